# Optimizing an MI355X kernel written in HIP

```python
import math
import jax, jax.numpy as jnp
from jax import lax
import numpy as np

D_MODEL = 1024
BATCH = 4
SEQ = 8192
DEPTH = 1

HEAD_DIM = 64
HEADS_PER_GROUP = 4
DILATED_PATTERNS = ((128, 1), (512, 4), (2048, 16))
N_GROUPS_A = 3
N_HEADS_A = N_GROUPS_A * HEADS_PER_GROUP
ATTN_WIDTH = N_HEADS_A * HEAD_DIM
ATTN_OUT_WIDTH = HEADS_PER_GROUP * HEAD_DIM
ALIBI_SPAN = 8.0
MASK_VALUE = -1e30
CONV_WIDTH = 768
CONV_K = 3
N_BRANCHES = 2
IN_COLS = 3 * ATTN_WIDTH + 3 * CONV_WIDTH + N_BRANCHES * D_MODEL
N_EXPERT_GROUPS = 4
EXPERTS_PER_GROUP = 8
N_EXPERTS = N_EXPERT_GROUPS * EXPERTS_PER_GROUP
TOP_K_WITHIN = 2
EXPERT_FF = 512
RMS_EPS = 1e-6

kernel_name = "hybrid_dilated_attn_shortconv_hmoe_encoder"


def rmsnorm(x, g):
    xf = x.astype(jnp.float32)
    y = xf * lax.rsqrt(jnp.mean(xf * xf, axis=-1, keepdims=True) + RMS_EPS) * g.astype(jnp.float32)
    return y.astype(x.dtype)


def alibi_slopes(n):
    return np.array([2.0 ** (-ALIBI_SPAN * (i + 1) / n) for i in range(n)], dtype=np.float32)


def dilated_window_attention(q, k, v, window, dilation, slopes):
    B, S, H, E = q.shape
    half = window // (2 * dilation)
    blk = half
    L = S // dilation
    nblk = -(-L // blk)
    Lp = nblk * blk

    def strided(a):
        return a.reshape(B, L, dilation, H, E).transpose(0, 2, 1, 3, 4)

    qs = jnp.pad(strided(q), ((0, 0), (0, 0), (0, Lp - L), (0, 0), (0, 0)))
    qs = qs.reshape(B, dilation, nblk, blk, H, E)

    def neighbours(a):
        ap = jnp.pad(strided(a), ((0, 0), (0, 0), (blk, Lp - L + blk), (0, 0), (0, 0)))
        return jnp.concatenate(
            [ap[:, :, s * blk:s * blk + Lp].reshape(B, dilation, nblk, blk, H, E) for s in range(3)],
            axis=3)

    ks = neighbours(k)
    vs = neighbours(v)
    scores = jnp.einsum('bdnqhe,bdnkhe->bdnhqk', qs, ks).astype(jnp.float32) * (E ** -0.5)

    qi = jnp.arange(blk)[:, None]
    kc = jnp.arange(3 * blk)[None, :]
    delta = kc - blk - qi
    key_pos = jnp.arange(nblk)[:, None, None] * blk - blk + kc[None]
    valid = (jnp.abs(delta) <= half)[None] & (key_pos >= 0) & (key_pos < L)
    dist = (jnp.abs(delta) * dilation).astype(jnp.float32)
    scores = scores - slopes.astype(jnp.float32)[:, None, None] * dist
    scores = jnp.where(valid[:, None], scores, MASK_VALUE)

    m = jnp.max(scores, axis=-1, keepdims=True)
    p = jnp.exp(scores - m)
    denom = jnp.sum(p, axis=-1, keepdims=True)
    out = jnp.einsum('bdnhqk,bdnkhe->bdnqhe', p, vs.astype(jnp.float32))
    out = out / jnp.moveaxis(denom, 3, 4)
    lse = jnp.moveaxis((m + jnp.log(denom))[..., 0], 3, 4)

    out = out.reshape(B, dilation, Lp, H, E)[:, :, :L].transpose(0, 2, 1, 3, 4).reshape(B, S, H, E)
    lse = lse.reshape(B, dilation, Lp, H)[:, :, :L].transpose(0, 2, 1, 3).reshape(B, S, H)
    return out, lse


def dilated_attention_mixer(q, k, v):
    B, S, _ = q.shape
    shp = (B, S, N_GROUPS_A, HEADS_PER_GROUP, HEAD_DIM)
    q, k, v = q.reshape(shp), k.reshape(shp), v.reshape(shp)
    slopes = jnp.asarray(alibi_slopes(N_HEADS_A).reshape(N_GROUPS_A, HEADS_PER_GROUP))
    outs, lses = [], []
    for g, (window, dilation) in enumerate(DILATED_PATTERNS):
        o, l = dilated_window_attention(q[:, :, g], k[:, :, g], v[:, :, g], window, dilation, slopes[g])
        outs.append(o)
        lses.append(l)
    outs = jnp.stack(outs, axis=0)
    w = jax.nn.softmax(jnp.stack(lses, axis=0), axis=0)
    merged = jnp.sum(w[..., None] * outs, axis=0)
    return merged.reshape(B, S, ATTN_OUT_WIDTH).astype(q.dtype)


def short_conv_mixer(b_gate, c_gate, x_in, conv_w):
    u = c_gate * x_in
    kern = conv_w.astype(u.dtype)[:, None, :]
    conv = lax.conv_general_dilated(u, kern, window_strides=(1,), padding=((CONV_K // 2, CONV_K // 2),),
                                    dimension_numbers=('NWC', 'WIO', 'NWC'), feature_group_count=CONV_WIDTH)
    return b_gate * conv


def hierarchical_moe(h, w_route_group, b_route_group, w_route_expert, b_route_expert, w1, w3, w2):
    B, S, D = h.shape
    t = h.reshape(B * S, D)
    coarse = (t @ w_route_group).astype(jnp.float32) + b_route_group.astype(jnp.float32)
    fine = (t @ w_route_expert).astype(jnp.float32) + b_route_expert.astype(jnp.float32)
    fine = fine.reshape(-1, N_EXPERT_GROUPS, EXPERTS_PER_GROUP)
    p_group = jax.nn.softmax(coarse, axis=-1)
    g_idx = lax.top_k(coarse, 1)[1][:, 0]
    pg = jnp.take_along_axis(p_group, g_idx[:, None], axis=1)[:, 0]
    fine_sel = jnp.take_along_axis(fine, g_idx[:, None, None], axis=1)[:, 0]
    p_exp = jax.nn.softmax(fine_sel, axis=-1)
    top_vals, top_idx = lax.top_k(p_exp, TOP_K_WITHIN)
    gate_w = pg[:, None] * top_vals / jnp.sum(top_vals, axis=-1, keepdims=True)
    expert_id = g_idx[:, None] * EXPERTS_PER_GROUP + top_idx
    combine = jnp.sum(jax.nn.one_hot(expert_id, N_EXPERTS, dtype=jnp.float32) * gate_w[..., None], axis=1)
    combine = combine.astype(t.dtype)
    out = jnp.zeros_like(t)
    for e in range(N_EXPERTS):
        hid = jax.nn.silu(t @ w1[e]) * (t @ w3[e])
        out = out + combine[:, e:e + 1] * (hid @ w2[e])
    return out.reshape(B, S, D)


def setup_inputs(seed: int = 0) -> dict:
    key = jax.random.key(seed)
    ks = jax.random.split(key, 20)
    f32 = jnp.float32
    D = D_MODEL

    def nrm(k, shape, fan_in):
        return jax.random.normal(k, shape, f32) * (fan_in ** -0.5)

    return {
        "x": jax.random.normal(ks[0], (BATCH, SEQ, D), f32),
        "norm_mix_g": 1.0 + 0.02 * jax.random.normal(ks[1], (DEPTH, D), f32),
        "w_in": nrm(ks[2], (DEPTH, D, IN_COLS), D),
        "b_gate": 0.01 * jax.random.normal(ks[3], (DEPTH, N_BRANCHES * D), f32),
        "conv_w": nrm(ks[4], (DEPTH, CONV_K, CONV_WIDTH), CONV_K),
        "w_attn_out": nrm(ks[5], (DEPTH, ATTN_OUT_WIDTH, D), ATTN_OUT_WIDTH),
        "w_conv_out": nrm(ks[6], (DEPTH, CONV_WIDTH, D), CONV_WIDTH),
        "w_out": nrm(ks[7], (DEPTH, D, D), D),
        "norm_ffn_g": 1.0 + 0.02 * jax.random.normal(ks[8], (DEPTH, D), f32),
        "w_route_group": nrm(ks[9], (DEPTH, D, N_EXPERT_GROUPS), D),
        "b_route_group": 0.01 * jax.random.normal(ks[10], (DEPTH, N_EXPERT_GROUPS), f32),
        "w_route_expert": nrm(ks[11], (DEPTH, D, N_EXPERTS), D),
        "b_route_expert": 0.01 * jax.random.normal(ks[12], (DEPTH, N_EXPERTS), f32),
        "w1": nrm(ks[13], (DEPTH, N_EXPERTS, D, EXPERT_FF), D),
        "w3": nrm(ks[14], (DEPTH, N_EXPERTS, D, EXPERT_FF), D),
        "w2": nrm(ks[15], (DEPTH, N_EXPERTS, EXPERT_FF, D), EXPERT_FF),
        "norm_final_g": 1.0 + 0.02 * jax.random.normal(ks[16], (D,), f32),
    }


def reference(x, norm_mix_g, w_in, b_gate, conv_w, w_attn_out, w_conv_out, w_out, norm_ffn_g,
              w_route_group, b_route_group, w_route_expert, b_route_expert, w1, w3, w2, norm_final_g):
    B, S, D = x.shape
    split_at = [ATTN_WIDTH, 2 * ATTN_WIDTH, 3 * ATTN_WIDTH,
                3 * ATTN_WIDTH + CONV_WIDTH, 3 * ATTN_WIDTH + 2 * CONV_WIDTH, 3 * ATTN_WIDTH + 3 * CONV_WIDTH]
    for l in range(DEPTH):
        h = rmsnorm(x, norm_mix_g[l])
        proj = h @ w_in[l]
        q, k, v, bg, cg, xin, gate_logits = jnp.split(proj, split_at, axis=-1)
        y_a = dilated_attention_mixer(q, k, v) @ w_attn_out[l]
        y_b = short_conv_mixer(bg, cg, xin, conv_w[l]) @ w_conv_out[l]
        gates = jax.nn.sigmoid(gate_logits + b_gate[l]).reshape(B, S, N_BRANCHES, D)
        merged = gates[:, :, 0] * y_a + gates[:, :, 1] * y_b
        x = x + merged @ w_out[l]
        h2 = rmsnorm(x, norm_ffn_g[l])
        x = x + hierarchical_moe(h2, w_route_group[l], b_route_group[l], w_route_expert[l],
                                 b_route_expert[l], w1[l], w3[l], w2[l])
    return rmsnorm(x, norm_final_g)
```

```cpp
#include <hip/hip_runtime.h>
#include <cstdio>
#include <cstdint>

#ifndef REPEAT_MASK
#define REPEAT_MASK 0
#endif
#define TWICE(k, ...) do { { __VA_ARGS__ } if ((REPEAT_MASK >> (k)) & 1) { __VA_ARGS__ } } while (0)
#ifndef FP8_SCALE_ARG
#define FP8_SCALE_ARG 0x7F7F7F7F
#endif
#ifndef EPI_ALIGN_OUT
#define EPI_ALIGN_OUT true
#endif
#ifndef MK_N_LAUNCHES
#define MK_N_LAUNCHES 1
#endif

constexpr int BATCH = 4, SEQ = 8192, D = 1024, T = BATCH * SEQ;
constexpr int NPROJ = 6656;
constexpr int PROJ_LD = 5888;
constexpr int PC_Q0 = 0, PC_BG = 256, PC_Q1 = 1024, PC_Q2 = 1280, PC_K = 1536, PC_V = 2304, PC_U = 3072, PC_G = 3840;
constexpr int PC_O = 0, PC_C = 256, PC_M = 1024;
constexpr int NEXP = 32, FF = 512, CAP = T;
constexpr int MAXSLOT = 73728;
constexpr float RMS_EPS = 1e-6f;
constexpr float LOG2E = 1.4426950408889634f;
constexpr float W13_SCALE = 64.0f, W2_SCALE = 32.0f, WQ_SCALE = 256.0f, WKV_SCALE = 32.0f, Y_SCALE = 16.0f;
constexpr float QSCALE = 0.125f * LOG2E;
constexpr float W8_CLIP = 4.0f * 0.03125f;

constexpr size_t MiB = 1u << 20;
constexpr size_t WS_CTL = 0, CTL_ZERO_BYTES = 128 * 1024;
constexpr size_t WS_RL = 1 * MiB;
constexpr size_t WS_TOKINFO = 1 * MiB;
constexpr size_t WS_IRS1 = 1 * MiB + 768 * 1024;
constexpr size_t WS_WRT = 1 * MiB + 512 * 1024;
constexpr size_t WS_WAC = 2 * MiB;
constexpr size_t WS_WO = 4 * MiB;
constexpr size_t WS_LIST = 6 * MiB;
constexpr size_t WS_WL = 10 * MiB;
constexpr size_t WS_RSL = 14 * MiB;
constexpr size_t WS_WIN = 18 * MiB;
constexpr size_t WS_X1B = 32 * MiB;
constexpr size_t WS_PROJ = 96 * MiB;
constexpr size_t WS_W13 = WS_PROJ;
constexpr size_t WS_W2 = WS_PROJ + 64 * MiB;
constexpr size_t WS_HID = WS_PROJ + 96 * MiB;
constexpr size_t WS_Y = WS_PROJ + 168 * MiB;
constexpr size_t WS_X1Q = 464 * MiB;
constexpr size_t WS_WINQ = 496 * MiB;
constexpr size_t WS_END = 501 * MiB;
static_assert(WS_PROJ + (size_t)T * PROJ_LD * 2 <= WS_END && WS_Y + (size_t)MAXSLOT * 1024 * 2 <= WS_END, "d_ws map");
constexpr int CW_TMO = 0;
constexpr int CW_BAR = 4096;
constexpr int CW_CNT = 16384;

constexpr int RING_BYTES = 131072;
constexpr int L_MISC = RING_BYTES;
constexpr int L_HIST = L_MISC + 512;
constexpr int L_LBASE = L_HIST + 128;
constexpr int L_CNT = L_LBASE + 128;
constexpr int L_TPRE = L_CNT + 128;
constexpr int L_NU = L_TPRE + 256;
constexpr int L_UTAB = L_NU + 128;
constexpr int L_GTAB = L_UTAB + 256;
constexpr int L_REC = L_GTAB + 6 * 1024;
constexpr int LDS_ZERO_END = L_LBASE;
constexpr int LDS_BYTES = 147456;
static_assert(L_REC + 128 * 32 <= LDS_BYTES, "LDS map");
constexpr int MAXU = 6;

#define GAS __attribute__((address_space(1)))
#define LAS __attribute__((address_space(3)))
typedef unsigned short bf16;
typedef unsigned v4u __attribute__((ext_vector_type(4)));
typedef unsigned v2u __attribute__((ext_vector_type(2)));
typedef int v4i __attribute__((ext_vector_type(4)));
typedef float f32x4 __attribute__((ext_vector_type(4)));
typedef GAS unsigned gu32;
#define RLX_AGENT __ATOMIC_RELAXED, __HIP_MEMORY_SCOPE_AGENT
#define LDS_WAIT() asm volatile("s_waitcnt lgkmcnt(0)" ::: "memory")
#define VM_WAIT() asm volatile("s_waitcnt vmcnt(0)" ::: "memory")
__device__ __forceinline__ unsigned f2bf(float f) { unsigned u = __builtin_bit_cast(unsigned, f); return (u + 0x7fffu + ((u >> 16) & 1u)) >> 16; }
__device__ __forceinline__ unsigned pk2(float lo, float hi) { return f2bf(lo) | (f2bf(hi) << 16); }
__device__ __forceinline__ float bflo(unsigned w) { return __builtin_bit_cast(float, w << 16); }
__device__ __forceinline__ float bfhi(unsigned w) { return __builtin_bit_cast(float, w & 0xffff0000u); }
__device__ __forceinline__ float fast_exp2(float x) { return __builtin_amdgcn_exp2f(x); }
__device__ __forceinline__ float fast_rcp(float x) { return __builtin_amdgcn_rcpf(x); }
__device__ __forceinline__ float sigmoidf_(float z) { return fast_rcp(1.0f + fast_exp2(-z * LOG2E)); }

namespace pg8 {
#define PG8_LAS __attribute__((address_space(3)))
typedef unsigned short bf16_t;
typedef short bf16x8 __attribute__((ext_vector_type(8)));
typedef float f32x4 __attribute__((ext_vector_type(4)));
typedef unsigned u32x4 __attribute__((ext_vector_type(4)));
typedef unsigned u32x2 __attribute__((ext_vector_type(2)));
constexpr int BM = 256, BK = 64, HALF = 128, HTB = HALF * BK * 2, STAGE_BYTES = 8 * HTB, NXCD = 8, WGM = 8;

__host__ __device__ __forceinline__ int lds_byte(int r, int c) { const int st = (r >> 4) * 2 + (c >> 5), rr = r & 15, cc = c & 31, ob = rr * 64 + cc * 2; return st * 1024 + (ob ^ (((ob >> 9) & 1) << 5)); }
__host__ __device__ __forceinline__ void stage_rc(int b, int& R, int& C) { const int st = b / 1024, sb = b % 1024, swz = sb ^ (((sb >> 9) & 1) << 5); R = (st >> 1) * 16 + swz / 64; C = (st & 1) * 32 + (swz % 64) / 2; }
__host__ __device__ __forceinline__ int perm32(int rho) { const int n = rho >> 4, i = rho & 15; return 8 * (i >> 2) + 4 * n + (i & 3); }

struct Unit { int pm, pn, e, pos0, rows; };
struct Gemm { const bf16_t* A; const bf16_t* Bt; int K, lda, ldb; };

struct StaticOrder {
    int nM, nN, nwg, G, c;
    __device__ void init(int M, int N, int G_, int c_) { nM = M / BM; nN = N / BM; nwg = nM * nN; G = G_; c = c_; }
    __device__ bool next(int i, Unit& u) const {
        const long L = (long)i * G + c; if (L >= nwg) return false;
        int wgid = (int)L; { const int q = nwg / NXCD, r = nwg % NXCD, xcd = wgid % NXCD, off = wgid / NXCD; wgid = (xcd < r ? xcd * (q + 1) : r * (q + 1) + (xcd - r) * q) + off; }
        const int nig = WGM * nN, gid = wgid / nig, fm = gid * WGM, gsz = (nM - fm) < WGM ? (nM - fm) : WGM;
        u.pm = fm + ((wgid % nig) % gsz); u.pn = (wgid % nig) / gsz; u.e = 0; u.pos0 = 0; u.rows = BM; return true;
    }
    __device__ __forceinline__ int gather_tok(int, int) const { return 0; }
};
template <bool QKV> struct MapOrder : StaticOrder {
    __device__ bool next(int i, Unit& u) const {
        if (!StaticOrder::next(i, u)) return false;
        if (QKV) { u.e = u.pn == 0 ? 0 : (u.pn < 9 ? u.pn + 3 : u.pn + 9); }
        else { u.pn = u.pn < 3 ? u.pn + 1 : u.pn + 9; u.e = u.pn; }
        return true;
    }
};
struct MoeOrder {
    const PG8_LAS int* utab; const PG8_LAS int* gtab; int n;
    __device__ __forceinline__ bool next(int i, Unit& u) const {
        if (i >= n) return false;
        u.pm = __builtin_amdgcn_readfirstlane(utab[i * 8 + 0]); u.pn = __builtin_amdgcn_readfirstlane(utab[i * 8 + 1]); u.e = __builtin_amdgcn_readfirstlane(utab[i * 8 + 2]);
        u.pos0 = __builtin_amdgcn_readfirstlane(utab[i * 8 + 3]); u.rows = __builtin_amdgcn_readfirstlane(utab[i * 8 + 4]); return true;
    }
    __device__ __forceinline__ int gather_tok(int ui, int r) const { return gtab[ui * 256 + r]; }
};

typedef float f32x2_t __attribute__((ext_vector_type(2))); typedef __bf16 bf16x2_t __attribute__((ext_vector_type(2)));
__device__ __forceinline__ unsigned cvt_pk_bf16(float lo, float hi) { const f32x2_t v = {lo, hi}; const bf16x2_t b = __builtin_convertvector(v, bf16x2_t); return __builtin_bit_cast(unsigned, b); }
__device__ __forceinline__ u32x4 pack8(const f32x4 v0, const f32x4 v1) { u32x4 w; w.x = cvt_pk_bf16(v0[0], v0[1]); w.y = cvt_pk_bf16(v0[2], v0[3]); w.z = cvt_pk_bf16(v1[0], v1[1]); w.w = cvt_pk_bf16(v1[2], v1[3]); return w; }

typedef int i32x8 __attribute__((ext_vector_type(8))); typedef int i32x4 __attribute__((ext_vector_type(4)));
__device__ __forceinline__ i32x8 cat8(const bf16x8 a, const bf16x8 b) { const i32x4 x = __builtin_bit_cast(i32x4, a), y = __builtin_bit_cast(i32x4, b); return __builtin_shufflevector(x, y, 0, 1, 2, 3, 4, 5, 6, 7); }
__device__ __forceinline__ void mfma_fp8_inplace(f32x4& acc, const i32x8 a, const i32x8 b) {
    asm volatile("v_mfma_f32_16x16x128_f8f6f4 %0, %1, %2, %0" : "+v"(acc) : "v"(a), "v"(b));
}
__device__ __forceinline__ u32x2 pack8_fp8(const f32x4 v0, const f32x4 v1) { u32x2 w; int t = 0; t = __builtin_amdgcn_cvt_pk_fp8_f32(v0[0], v0[1], t, false); t = __builtin_amdgcn_cvt_pk_fp8_f32(v0[2], v0[3], t, true); w.x = (unsigned)t;
    t = 0; t = __builtin_amdgcn_cvt_pk_fp8_f32(v1[0], v1[1], t, false); t = __builtin_amdgcn_cvt_pk_fp8_f32(v1[2], v1[3], t, true); w.y = (unsigned)t; return w; }
template <class Epi, class Sched, bool ALIGN_EPI, bool GATHER, int QM = 0>
__device__ __forceinline__ void gemm_phase(PG8_LAS unsigned char* lds, const Gemm g, const Sched& S, const Epi& E) {
    const int tid = threadIdx.x, wid = __builtin_amdgcn_readfirstlane(tid >> 6), lane = tid & 63, wr = wid >> 2, wc = wid & 3, fr = lane & 15, fq = lane >> 4;
    const int K = g.K, nt = K / BK;
    const unsigned ldaB = (unsigned)g.lda * 2u, ldbB = (unsigned)g.ldb * 2u;
    int RA[2]; unsigned cA2[2], vB0[2], vB1[2];
#pragma unroll
    for (int i = 0; i < 2; ++i) { int R, C; stage_rc(tid * 16 + i * 8192, R, C); const int Rb = Epi::PERM ? ((R & ~31) + perm32(R & 31)) : R;
        RA[i] = R; cA2[i] = (unsigned)C * 2u; vB0[i] = (unsigned)Rb * ldbB + (unsigned)C * 2u; vB1[i] = vB0[i] + (unsigned)HALF * ldbB; }
    const size_t kstep = (size_t)(BK * 2);
    const size_t tstepA = (size_t)BM * ldaB, tstepB = (size_t)BM * ldbB;
    const unsigned ldsw = (unsigned)wid * 1024u;
    constexpr bool FP8 = (QM == 1);
    const int aoff = lds_byte(wr * 64 + fr, fq * 8), boff = lds_byte(wc * 32 + fr, fq * 8);
    constexpr int KSTR = 1024;
#define PG8_SA(b, h) (((b) * 2 + (h)) * HTB)
#define PG8_SB(b, h) ((4 + (b) * 2 + (h)) * HTB)
#define PG8_STAGE(bufoff, gbase, voff) do { _Pragma("unroll") for (int _i = 0; _i < 2; ++_i) \
        __builtin_amdgcn_global_load_lds((const unsigned*)((const char*)(gbase) + (voff)[_i]), (PG8_LAS unsigned*)(lds + (bufoff) + ldsw + _i * 8192), 16, 0, 0); } while (0)
#define PG8_LDA(dst, b, h) do { _Pragma("unroll") for (int m = 0; m < 4; ++m) _Pragma("unroll") for (int k = 0; k < 2; ++k) dst[m][k] = *(const PG8_LAS bf16x8*)(lds + PG8_SA(b, h) + aoff + m * 2048 + k * KSTR); } while (0)
#define PG8_LDB(dst, b, h) do { _Pragma("unroll") for (int n = 0; n < 2; ++n) _Pragma("unroll") for (int k = 0; k < 2; ++k) dst[n][k] = *(const PG8_LAS bf16x8*)(lds + PG8_SB(b, h) + boff + n * 2048 + k * KSTR); } while (0)
#define PG8_MMA(ai, bj, At, Bt) do { __builtin_amdgcn_s_setprio(1); _Pragma("unroll") for (int m = 0; m < 4; ++m) _Pragma("unroll") for (int n = 0; n < 2; ++n) { \
        if constexpr (FP8) { mfma_fp8_inplace(acc[ai][bj][m][n], cat8(Bt[n][0], Bt[n][1]), cat8(At[m][0], At[m][1])); } \
        else if constexpr (QM == 2) { _Pragma("unroll") for (int k = 0; k < 2; ++k) acc[ai][bj][m][n] = __builtin_bit_cast(f32x4, __builtin_amdgcn_mfma_i32_16x16x64_i8(__builtin_bit_cast(i32x4, Bt[n][k]), __builtin_bit_cast(i32x4, At[m][k]), __builtin_bit_cast(i32x4, acc[ai][bj][m][n]), 0, 0, 0)); } \
        else { _Pragma("unroll") for (int k = 0; k < 2; ++k) acc[ai][bj][m][n] = __builtin_amdgcn_mfma_f32_16x16x32_bf16(Bt[n][k], At[m][k], acc[ai][bj][m][n], 0, 0, 0); } } \
        __builtin_amdgcn_s_setprio(0); } while (0)
#define PG8_WAIT_V(n) asm volatile("s_waitcnt vmcnt(" #n ")" ::: "memory")
#define PG8_WAIT_L(n) asm volatile("s_waitcnt lgkmcnt(" #n ")" ::: "memory")
#define PG8_BAR __builtin_amdgcn_s_barrier()
#define PG8_SCHED __builtin_amdgcn_sched_barrier(0)
#define PG8_SETA(v, ui) do { _Pragma("unroll") for (int _i = 0; _i < 2; ++_i) { \
        if constexpr (GATHER) { (v)[0][_i] = (unsigned)S.gather_tok((ui), RA[_i]) * ldaB + cA2[_i]; (v)[1][_i] = (unsigned)S.gather_tok((ui), RA[_i] + HALF) * ldaB + cA2[_i]; } \
        else { (v)[0][_i] = (unsigned)RA[_i] * ldaB + cA2[_i]; (v)[1][_i] = (v)[0][_i] + (unsigned)HALF * ldaB; } } } while (0)
    Unit cur, nxt; int ui = 0;
    if (!S.next(0, cur)) return;
    f32x4 acc[2][2][4][2];
#pragma unroll
    for (int a = 0; a < 2; ++a)
#pragma unroll
        for (int b = 0; b < 2; ++b)
#pragma unroll
            for (int m = 0; m < 4; ++m)
#pragma unroll
                for (int n = 0; n < 2; ++n) acc[a][b][m][n] = (f32x4){0.f, 0.f, 0.f, 0.f};
    bf16x8 At[4][2], B0[2][2], B1[2][2];
    unsigned vA[2][2], nvA[2][2];
    PG8_SETA(vA, 0);
#pragma unroll
    for (int i = 0; i < 2; ++i) { nvA[0][i] = vA[0][i]; nvA[1][i] = vA[1][i]; }
    const char* cA = GATHER ? (const char*)g.A : (const char*)g.A + (size_t)cur.pm * tstepA; const char* cB = (const char*)g.Bt + (size_t)cur.pn * tstepB;
    PG8_STAGE(PG8_SB(0, 0), cB, vB0); PG8_STAGE(PG8_SB(0, 1), cB, vB1); PG8_STAGE(PG8_SA(0, 0), cA, vA[0]); PG8_STAGE(PG8_SA(0, 1), cA, vA[1]);
    if (wr == 1) PG8_BAR;
    PG8_WAIT_V(2); PG8_BAR;
    PG8_STAGE(PG8_SB(1, 0), cB + kstep, vB0); PG8_STAGE(PG8_SA(1, 0), cA + kstep, vA[0]); PG8_STAGE(PG8_SB(1, 1), cB + kstep, vB1);
    PG8_WAIT_V(6); PG8_BAR;
    for (;;) {
        const bool has_next = S.next(ui + 1, nxt);
        const char* nA = GATHER ? cA : (has_next ? (const char*)g.A + (size_t)nxt.pm * tstepA : cA);
        const char* nB = has_next ? (const char*)g.Bt + (size_t)nxt.pn * tstepB : cB;
        if constexpr (GATHER) { if (has_next) { PG8_SETA(nvA, ui + 1); } }
#pragma unroll 1
        for (int t = 0; t < nt; t += 2) {
            if constexpr (FP8) asm volatile("" : "+v"(vA[0][0]), "+v"(vA[0][1]), "+v"(vA[1][0]), "+v"(vA[1][1]), "+v"(vB0[0]), "+v"(vB0[1]), "+v"(vB1[0]), "+v"(vB1[1]));
            const bool last = (t == nt - 2);
            const char* a1 = cA + (size_t)(t + 1) * kstep;
            const char* a2 = last ? nA : cA + (size_t)(t + 2) * kstep; const char* b2 = last ? nB : cB + (size_t)(t + 2) * kstep;
            const char* a3 = a2 + kstep; const char* b3 = b2 + kstep;
            unsigned w0[2], w1[2];
#pragma unroll
            for (int i = 0; i < 2; ++i) { if constexpr (GATHER) { w0[i] = last ? nvA[0][i] : vA[0][i]; w1[i] = last ? nvA[1][i] : vA[1][i]; } else { w0[i] = vA[0][i]; w1[i] = vA[1][i]; } }
            PG8_LDB(B0, 0, 0); PG8_LDB(B1, 0, 1); PG8_SCHED; PG8_LDA(At, 0, 0); PG8_STAGE(PG8_SA(1, 1), a1, vA[1]);
            PG8_WAIT_V(8); PG8_WAIT_L(0); PG8_BAR; PG8_MMA(0, 0, At, B0); PG8_MMA(0, 1, At, B1); PG8_BAR; PG8_SCHED;
            PG8_LDA(At, 0, 1); PG8_STAGE(PG8_SB(0, 0), b2, vB0); PG8_STAGE(PG8_SB(0, 1), b2, vB1); PG8_STAGE(PG8_SA(0, 0), a2, w0);
            PG8_WAIT_V(8); PG8_WAIT_L(0); PG8_BAR; PG8_MMA(1, 0, At, B0); PG8_MMA(1, 1, At, B1); PG8_BAR; PG8_SCHED;
            PG8_LDB(B0, 1, 0); PG8_LDB(B1, 1, 1); PG8_SCHED; PG8_LDA(At, 1, 0); PG8_STAGE(PG8_SA(0, 1), a2, w1);
            PG8_WAIT_V(8); PG8_WAIT_L(0); PG8_BAR; PG8_MMA(0, 0, At, B0); PG8_MMA(0, 1, At, B1); PG8_BAR; PG8_SCHED;
            PG8_LDA(At, 1, 1); PG8_STAGE(PG8_SB(1, 0), b3, vB0); PG8_STAGE(PG8_SB(1, 1), b3, vB1); PG8_STAGE(PG8_SA(1, 0), a3, w0);
            PG8_WAIT_V(8); PG8_WAIT_L(0); PG8_BAR; PG8_MMA(1, 0, At, B0); PG8_MMA(1, 1, At, B1); PG8_BAR; PG8_SCHED;
            if constexpr (Epi::HAS_MID) { if (t == Epi::MID_T) E.mid(acc, cur, wr, wc, fr, fq); }
        }
        if constexpr (FP8) asm volatile("s_nop 15\n\ts_nop 15" ::: "memory");
        if constexpr (ALIGN_EPI) { if (wr == 0) PG8_BAR; }
        E(acc, cur, wr, wc, fr, fq);
        if (!has_next) break;
#pragma unroll
        for (int a = 0; a < 2; ++a)
#pragma unroll
            for (int b = 0; b < 2; ++b)
#pragma unroll
                for (int m = 0; m < 4; ++m)
#pragma unroll
                    for (int n = 0; n < 2; ++n) acc[a][b][m][n] = (f32x4){0.f, 0.f, 0.f, 0.f};
        cur = nxt; cA = nA; cB = nB; ++ui;
        if constexpr (GATHER) {
#pragma unroll
            for (int i = 0; i < 2; ++i) { vA[0][i] = nvA[0][i]; vA[1][i] = nvA[1][i]; }
        }
        if constexpr (ALIGN_EPI) { if (wr == 1) PG8_BAR; }
    }
    PG8_WAIT_V(0);
    if constexpr (!ALIGN_EPI) { if (wr == 0) PG8_BAR; }
    PG8_BAR;
#undef PG8_SA
#undef PG8_SB
#undef PG8_STAGE
#undef PG8_LDA
#undef PG8_LDB
#undef PG8_MMA
#undef PG8_WAIT_V
#undef PG8_WAIT_L
#undef PG8_BAR
#undef PG8_SCHED
#undef PG8_SETA
}

struct EpiProj {
    static constexpr bool PERM = true, HAS_MID = false; static constexpr int MID_T = -1;
    bf16_t* P; const float* bgate;
    __device__ __forceinline__ void mid(f32x4 (&)[2][2][4][2], const Unit&, int, int, int, int) const {}
    __device__ __forceinline__ void operator()(const f32x4 (&acc)[2][2][4][2], const Unit& u, int wr, int wc, int fr, int fq) const {
        asm volatile("" : "+v"(fr), "+v"(fq));
        const int row0 = u.pm * BM + wr * 64 + fr; const int pn = u.e;
        if (pn < 12) {
            const int col0 = pn * 256 + wc * 32 + 8 * fq;
#pragma unroll
            for (int ai = 0; ai < 2; ++ai)
#pragma unroll
                for (int m = 0; m < 4; ++m) { bf16_t* rowp = P + (size_t)(row0 + ai * HALF + m * 16) * PROJ_LD + col0;
#pragma unroll
                    for (int bj = 0; bj < 2; ++bj) *(u32x4*)(rowp + bj * HALF) = pack8(acc[ai][bj][m][0], acc[ai][bj][m][1]); }
        } else if (pn < 18) {
            const int col0 = PC_U + (pn - 12) * 128 + wc * 32 + 8 * fq;
#pragma unroll
            for (int ai = 0; ai < 2; ++ai)
#pragma unroll
                for (int m = 0; m < 4; ++m) { bf16_t* rowp = P + (size_t)(row0 + ai * HALF + m * 16) * PROJ_LD + col0;
                    *(u32x4*)rowp = pack8(acc[ai][0][m][0] * acc[ai][1][m][0], acc[ai][0][m][1] * acc[ai][1][m][1]); }
        } else {
            const int cg0 = (pn - 18) * 256 + wc * 32 + 8 * fq;
            f32x4 bv[2][2];
#pragma unroll
            for (int bj = 0; bj < 2; ++bj)
#pragma unroll
                for (int n = 0; n < 2; ++n) bv[bj][n] = *(const f32x4*)(bgate + cg0 + bj * HALF + 4 * n);
#pragma unroll
            for (int ai = 0; ai < 2; ++ai)
#pragma unroll
                for (int m = 0; m < 4; ++m) { bf16_t* rowp = P + (size_t)(row0 + ai * HALF + m * 16) * PROJ_LD + PC_G + cg0;
#pragma unroll
                    for (int bj = 0; bj < 2; ++bj) { f32x4 z0 = acc[ai][bj][m][0] + bv[bj][0], z1 = acc[ai][bj][m][1] + bv[bj][1];
#if !defined(DBG_NO_SIG)
#pragma unroll
                        for (int j = 0; j < 4; ++j) { z0[j] = sigmoidf_(z0[j]); z1[j] = sigmoidf_(z1[j]); }
#endif
                        *(u32x4*)(rowp + bj * HALF) = pack8(z0, z1); } }
        }
    }
};
struct EpiProjI8 {
    static constexpr bool PERM = true, HAS_MID = false; static constexpr int MID_T = -1;
    bf16_t* P; const float* bgate; const float* sx;
    __device__ __forceinline__ void mid(f32x4 (&)[2][2][4][2], const Unit&, int, int, int, int) const {}
    __device__ __forceinline__ f32x4 deq(const f32x4 a, float s) const { const i32x4 ai = __builtin_bit_cast(i32x4, a); return __builtin_convertvector(ai, f32x4) * s; }
    __device__ __forceinline__ void operator()(const f32x4 (&acc)[2][2][4][2], const Unit& u, int wr, int wc, int fr, int fq) const {
        asm volatile("" : "+v"(fr), "+v"(fq));
        const int row0 = u.pm * BM + wr * 64 + fr; const int pn = u.pn;
        const float sw = (pn == 0 || pn == 4 || pn == 5) ? (W8_CLIP * QSCALE / 127.0f) : (W8_CLIP / 127.0f);
        if (pn >= 6 && pn < 12) {
            const int col0 = (pn - 6) * 256 + wc * 32 + 8 * fq;
#pragma unroll
            for (int ai = 0; ai < 2; ++ai)
#pragma unroll
                for (int m = 0; m < 4; ++m) { const int row = row0 + ai * HALF + m * 16; const float s_ = sx[row] * sw; unsigned char* rowp = (unsigned char*)(P + (size_t)row * PROJ_LD + PC_K) + col0;
#pragma unroll
                    for (int bj = 0; bj < 2; ++bj) *(u32x2*)(rowp + bj * HALF) = pack8_fp8(deq(acc[ai][bj][m][0], s_), deq(acc[ai][bj][m][1], s_)); }
        } else if (pn < 12) {
            const int col0 = pn * 256 + wc * 32 + 8 * fq;
#pragma unroll
            for (int ai = 0; ai < 2; ++ai)
#pragma unroll
                for (int m = 0; m < 4; ++m) { const int row = row0 + ai * HALF + m * 16; const float s_ = sx[row] * sw; bf16_t* rowp = P + (size_t)row * PROJ_LD + col0;
#pragma unroll
                    for (int bj = 0; bj < 2; ++bj) *(u32x4*)(rowp + bj * HALF) = pack8(deq(acc[ai][bj][m][0], s_), deq(acc[ai][bj][m][1], s_)); }
        } else if (pn < 18) {
            const int col0 = PC_U + (pn - 12) * 128 + wc * 32 + 8 * fq;
#pragma unroll
            for (int ai = 0; ai < 2; ++ai)
#pragma unroll
                for (int m = 0; m < 4; ++m) { const int row = row0 + ai * HALF + m * 16; const float s_ = sx[row] * sw; bf16_t* rowp = P + (size_t)row * PROJ_LD + col0;
                    *(u32x4*)rowp = pack8(deq(acc[ai][0][m][0], s_) * deq(acc[ai][1][m][0], s_), deq(acc[ai][0][m][1], s_) * deq(acc[ai][1][m][1], s_)); }
        } else {
            const int cg0 = (pn - 18) * 256 + wc * 32 + 8 * fq;
            f32x4 bv[2][2];
#pragma unroll
            for (int bj = 0; bj < 2; ++bj)
#pragma unroll
                for (int n = 0; n < 2; ++n) bv[bj][n] = *(const f32x4*)(bgate + cg0 + bj * HALF + 4 * n) * (-LOG2E);
#pragma unroll
            for (int ai = 0; ai < 2; ++ai)
#pragma unroll
                for (int m = 0; m < 4; ++m) { const int row = row0 + ai * HALF + m * 16; const float s_ = sx[row] * sw * (-LOG2E); unsigned char* rowp = (unsigned char*)(P + (size_t)row * PROJ_LD + PC_G) + cg0;
#pragma unroll
                    for (int bj = 0; bj < 2; ++bj) { const f32x4 z0 = deq(acc[ai][bj][m][0], s_) + bv[bj][0], z1 = deq(acc[ai][bj][m][1], s_) + bv[bj][1];
                        u32x2 w8; unsigned t0 = 0u, t1 = 0u;
#pragma unroll
                        for (int j = 0; j < 4; ++j) {
                            t0 = __builtin_amdgcn_cvt_pk_u8_f32(__builtin_rintf(fast_rcp(fast_exp2(z0[j]) * (1.0f / 255.0f) + (1.0f / 255.0f))), j, t0);
                            t1 = __builtin_amdgcn_cvt_pk_u8_f32(__builtin_rintf(fast_rcp(fast_exp2(z1[j]) * (1.0f / 255.0f) + (1.0f / 255.0f))), j, t1); }
                        w8.x = t0; w8.y = t1;
                        *(u32x2*)(rowp + bj * HALF) = w8; } }
        }
    }
};
struct EpiProjQ {
    static constexpr bool PERM = true, HAS_MID = false; static constexpr int MID_T = -1;
    bf16_t* P; const float* bgate;
    __device__ __forceinline__ void mid(f32x4 (&)[2][2][4][2], const Unit&, int, int, int, int) const {}
    __device__ __forceinline__ void operator()(const f32x4 (&acc)[2][2][4][2], const Unit& u, int wr, int wc, int fr, int fq) const {
        asm volatile("" : "+v"(fr), "+v"(fq));
        const int row0 = u.pm * BM + wr * 64 + fr; const int pn = u.e; const float sc = (pn == 0 || pn == 4 || pn == 5) ? (1.0f / WQ_SCALE) : (1.0f / WKV_SCALE);
        if (pn >= 18) {
            const int cg0 = (pn - 18) * 256 + wc * 32 + 8 * fq;
            f32x4 bv[2][2];
#pragma unroll
            for (int bj = 0; bj < 2; ++bj)
#pragma unroll
                for (int n = 0; n < 2; ++n) bv[bj][n] = *(const f32x4*)(bgate + cg0 + bj * HALF + 4 * n);
#pragma unroll
            for (int ai = 0; ai < 2; ++ai)
#pragma unroll
                for (int m = 0; m < 4; ++m) { bf16_t* rowp = P + (size_t)(row0 + ai * HALF + m * 16) * PROJ_LD + PC_G + cg0;
#pragma unroll
                    for (int bj = 0; bj < 2; ++bj) { f32x4 z0 = acc[ai][bj][m][0] * sc + bv[bj][0], z1 = acc[ai][bj][m][1] * sc + bv[bj][1];
#pragma unroll
                        for (int j = 0; j < 4; ++j) { z0[j] = sigmoidf_(z0[j]); z1[j] = sigmoidf_(z1[j]); }
                        *(u32x4*)(rowp + bj * HALF) = pack8(z0, z1); } }
            return;
        }
        const int col0 = pn * 256 + wc * 32 + 8 * fq;
#pragma unroll
        for (int ai = 0; ai < 2; ++ai)
#pragma unroll
            for (int m = 0; m < 4; ++m) { bf16_t* rowp = P + (size_t)(row0 + ai * HALF + m * 16) * PROJ_LD + col0;
#pragma unroll
                for (int bj = 0; bj < 2; ++bj) *(u32x4*)(rowp + bj * HALF) = pack8(acc[ai][bj][m][0] * sc, acc[ai][bj][m][1] * sc); }
    }
};
struct EpiMerged {
#if defined(DBG_NO_HOOK)
    static constexpr bool PERM = true, HAS_MID = false; static constexpr int MID_T = 2;
#else
    static constexpr bool PERM = true, HAS_MID = true; static constexpr int MID_T = 2;
#endif
    bf16_t* P;
    static __device__ __forceinline__ float ub(unsigned w, int i) { return (float)((w >> (8 * i)) & 0xffu); }
    __device__ __forceinline__ void mid(f32x4 (&acc)[2][2][4][2], const Unit& u, int wr, int wc, int fr, int fq) const {
        int row0 = u.pm * BM + wr * 64 + fr; int col0 = u.pn * 256 + wc * 32 + 8 * fq;
        asm volatile("" : "+v"(row0), "+v"(col0));
#pragma unroll
        for (int ai = 0; ai < 2; ++ai)
#pragma unroll
            for (int m = 0; m < 4; ++m) { const unsigned char* gp = (const unsigned char*)(P + (size_t)(row0 + ai * HALF + m * 16) * PROJ_LD + PC_G) + col0;
#pragma unroll
                for (int bj = 0; bj < 2; ++bj) { const u32x2 a = *(const u32x2*)(gp + bj * HALF), b = *(const u32x2*)(gp + 1024 + bj * HALF);
#pragma unroll
                    for (int n = 0; n < 2; ++n)
#pragma unroll
                        for (int i = 0; i < 4; ++i) acc[ai][bj][m][n][i] *= ub(a[n], i) * fast_rcp(fmaxf(ub(b[n], i), 1.0f)); }
                asm volatile("" ::: "memory"); }
    }
    __device__ __forceinline__ void operator()(const f32x4 (&acc)[2][2][4][2], const Unit& u, int wr, int wc, int fr, int fq) const {
        asm volatile("" : "+v"(fr), "+v"(fq));
        int row0 = u.pm * BM + wr * 64 + fr; int col0 = u.pn * 256 + wc * 32 + 8 * fq;
        asm volatile("" : "+v"(row0), "+v"(col0));
#pragma unroll
        for (int ai = 0; ai < 2; ++ai)
#pragma unroll
            for (int m = 0; m < 4; ++m) { bf16_t* rp = P + (size_t)(row0 + ai * HALF + m * 16) * PROJ_LD;
#pragma unroll
                for (int bj = 0; bj < 2; ++bj) { const u32x2 b = *(const u32x2*)((const unsigned char*)(rp + PC_G) + 1024 + col0 + bj * HALF);
                    f32x4 v0 = acc[ai][bj][m][0], v1 = acc[ai][bj][m][1];
#pragma unroll
                    for (int i = 0; i < 4; ++i) { v0[i] *= fmaxf(ub(b.x, i), 1.0f) * (1.0f / 255.0f); v1[i] *= fmaxf(ub(b.y, i), 1.0f) * (1.0f / 255.0f); }
                    *(u32x4*)(rp + PC_M + col0 + bj * HALF) = pack8(v0, v1); }
                asm volatile("" ::: "memory"); }
    }
};
struct EpiOut {
    static constexpr bool PERM = true, HAS_MID = false; static constexpr int MID_T = -1;
    const float* x; bf16_t* x1b; unsigned char* x1q;
    __device__ __forceinline__ void mid(f32x4 (&)[2][2][4][2], const Unit&, int, int, int, int) const {}
    __device__ __forceinline__ void operator()(const f32x4 (&acc)[2][2][4][2], const Unit& u, int wr, int wc, int fr, int fq) const {
        asm volatile("" : "+v"(fr), "+v"(fq));
        const int row0 = u.pm * BM + wr * 64 + fr; const int col0 = u.pn * 256 + wc * 32 + 8 * fq;
#pragma unroll
        for (int ai = 0; ai < 2; ++ai)
#pragma unroll
            for (int m = 0; m < 4; ++m) { const size_t off = (size_t)(row0 + ai * HALF + m * 16) * D + col0;
#pragma unroll
                for (int bj = 0; bj < 2; ++bj) { const f32x4 o0 = *(const f32x4*)(x + off + bj * HALF) + acc[ai][bj][m][0], o1 = *(const f32x4*)(x + off + bj * HALF + 4) + acc[ai][bj][m][1];
                    *(u32x4*)(x1b + off + bj * HALF) = pack8(o0, o1); *(u32x2*)(x1q + off + bj * HALF) = pack8_fp8(o0, o1); } }
    }
};
struct EpiHid {
    static constexpr bool PERM = true, HAS_MID = false; static constexpr int MID_T = -1;
    unsigned char* H; const float* rsl;
    __device__ __forceinline__ void mid(f32x4 (&)[2][2][4][2], const Unit&, int, int, int, int) const {}
    __device__ __forceinline__ void operator()(const f32x4 (&acc)[2][2][4][2], const Unit& u, int wr, int wc, int fr, int fq) const {
        asm volatile("" : "+v"(fr), "+v"(fq));
        const int rl0 = wr * 64 + fr; const int col0 = (u.pn & 3) * 128 + wc * 32 + 8 * fq;
#pragma unroll
        for (int ai = 0; ai < 2; ++ai)
#pragma unroll
            for (int m = 0; m < 4; ++m) { const int rl = rl0 + ai * HALF + m * 16; const float rs = rl < u.rows ? rsl[(size_t)u.e * CAP + u.pos0 + rl] * (1.0f / W13_SCALE) : 0.f;
                f32x4 h0, h1;
#pragma unroll
                for (int j = 0; j < 4; ++j) { const float a0 = acc[ai][0][m][0][j] * rs, b0 = acc[ai][1][m][0][j] * rs, a1 = acc[ai][0][m][1][j] * rs, b1 = acc[ai][1][m][1][j] * rs;
                    h0[j] = a0 * sigmoidf_(a0) * b0; h1[j] = a1 * sigmoidf_(a1) * b1; }
                *(u32x2*)(H + (size_t)(u.pm * BM + rl) * FF + col0) = pack8_fp8(h0, h1); }
    }
};
struct EpiY {
    static constexpr bool PERM = true, HAS_MID = false; static constexpr int MID_T = -1;
    unsigned char* Y; const float* wl;
    __device__ __forceinline__ void mid(f32x4 (&)[2][2][4][2], const Unit&, int, int, int, int) const {}
    __device__ __forceinline__ void operator()(const f32x4 (&acc)[2][2][4][2], const Unit& u, int wr, int wc, int fr, int fq) const {
        asm volatile("" : "+v"(fr), "+v"(fq));
        const int rl0 = wr * 64 + fr; const int col0 = (u.pn & 3) * 256 + wc * 32 + 8 * fq;
#pragma unroll
        for (int ai = 0; ai < 2; ++ai)
#pragma unroll
            for (int m = 0; m < 4; ++m) { const int rl = rl0 + ai * HALF + m * 16; const float w = rl < u.rows ? wl[(size_t)u.e * CAP + u.pos0 + rl] * (Y_SCALE / W2_SCALE) : 0.f;
                unsigned char* rp = Y + (size_t)(u.pm * BM + rl) * D + col0;
#pragma unroll
                for (int bj = 0; bj < 2; ++bj) *(u32x2*)(rp + bj * HALF) = pack8_fp8(acc[ai][bj][m][0] * w, acc[ai][bj][m][1] * w); }
    }
};
}

#define XB_TMO      128
#define XB_XCNT(j)  (256  + 64 * (j))
#define XB_XSUB(j)  (1280 + 64 * (j))
#define XB_XGEN(j)  (2304 + 64 * (j))
#define XB_TOP      3328
#define XB_TOPGEN   3392
#define XCD_BAR_WORDS 3456
#define XB_SPIN_CAP (1u << 18)
__device__ __forceinline__ unsigned xb_ld(unsigned* p)              { return __hip_atomic_load(p, __ATOMIC_RELAXED, __HIP_MEMORY_SCOPE_AGENT); }
__device__ __forceinline__ unsigned xb_add(unsigned* p, unsigned v) { return __hip_atomic_fetch_add(p, v, __ATOMIC_RELAXED, __HIP_MEMORY_SCOPE_AGENT); }
__device__ __forceinline__ unsigned xb_xcc_id() { return (unsigned)__builtin_amdgcn_s_getreg((3 << 11) | 20) & 0xFu; }
#define XB_SPIN(cond, bar) do { unsigned _sp = 0; while (cond) { __builtin_amdgcn_s_sleep(1); \
    if ((++_sp & 255u) == 0u) { if (xb_ld(&(bar)[XB_TMO])) break; if (_sp > XB_SPIN_CAP) { atomicAdd(&(bar)[XB_TMO], 1u); break; } } } } while (0)
struct XcdBarrier { unsigned* bar; unsigned x; volatile LAS unsigned* st; };
__device__ __forceinline__ XcdBarrier xcd_barrier_post(unsigned* bar, volatile LAS unsigned* st) {
    XcdBarrier b; b.bar = bar; b.x = xb_xcc_id(); b.st = st;
    if (threadIdx.x == 0) (void)xb_add(&bar[XB_XCNT(b.x)], 1u);
    return b;
}
__device__ __forceinline__ void xcd_barrier_complete(unsigned* bar, unsigned x, unsigned& nloc, unsigned& nx) {
    const unsigned G = gridDim.x * gridDim.y * gridDim.z;
    unsigned sum, cnt, mine, sp = 0u;
    for (;;) {
        sum = 0u; cnt = 0u; mine = 0u;
#pragma unroll
        for (unsigned j = 0; j < 16; ++j) { const unsigned c = xb_ld(&bar[XB_XCNT(j)]); sum += c; cnt += (c > 0u) ? 1u : 0u; mine = (j == x) ? c : mine; }
        if (sum == G) break;
        __builtin_amdgcn_s_sleep(1);
        if ((++sp & 255u) == 0u) { if (xb_ld(&bar[XB_TMO])) break; if (sp > XB_SPIN_CAP) { atomicAdd(&bar[XB_TMO], 1u); break; } }
    }
    nloc = mine > 0u ? mine : 1u; nx = cnt > 0u ? cnt : 1u;
}
__device__ __forceinline__ void xcd_barrier(const XcdBarrier& b) {
    asm volatile("s_waitcnt vmcnt(0)" ::: "memory");
    __syncthreads();
    if (threadIdx.x == 0) {
        unsigned* bar = b.bar;
        __builtin_amdgcn_s_waitcnt(0);
        unsigned nloc = b.st[0], nx = b.st[1];
        if (nloc == 0u) { xcd_barrier_complete(bar, b.x, nloc, nx); b.st[0] = nloc; b.st[1] = nx; }
        const unsigned old = xb_add(&bar[XB_XSUB(b.x)], 1u);
        const unsigned gen = old / nloc;
        if (old + 1u == (gen + 1u) * nloc) {
            __builtin_amdgcn_fence(__ATOMIC_RELEASE, "agent");
            asm volatile("s_waitcnt vmcnt(0)" ::: "memory");
            const unsigned og = xb_add(&bar[XB_TOP], 1u);
            const unsigned tg = og / nx;
            if (og + 1u == (tg + 1u) * nx) xb_add(&bar[XB_TOPGEN], 1u);
            else XB_SPIN(xb_ld(&bar[XB_TOPGEN]) == tg, bar);
            __builtin_amdgcn_fence(__ATOMIC_ACQUIRE, "agent");
            xb_add(&bar[XB_XGEN(b.x)], 1u);
            asm volatile("s_waitcnt vmcnt(0)" ::: "memory");
        } else {
            XB_SPIN(xb_ld(&bar[XB_XGEN(b.x)]) == gen, bar);
            __builtin_amdgcn_fence(__ATOMIC_ACQUIRE, "agent");
            asm volatile("s_waitcnt vmcnt(0)" ::: "memory");
        }
    }
    __syncthreads();
}

constexpr int NWAVES = 8;
struct Frame {
    LAS unsigned char* lds;
    gu32* ctl;
    int tid, lane, wave;
    int vcu, G;
    const float *x, *g_mix, *w_in, *b_gate, *conv_w, *w_ao, *w_co, *w_out, *g_ffn, *w_rg, *b_rg, *w_re, *b_re, *w1, *w3, *w2, *g_fin;
    float* out;
    bf16 *WinT, *WacT, *WoT, *PROJ, *XN, *X1B; unsigned char* Y; float* irs1;
    unsigned char *W13Q, *W2Q, *X1Q, *HIDQ, *XNQ, *WinQ;
    int* list; float* wl; float* rsl; int* tokinfo; float* WrT;
};
__device__ __forceinline__ float wave_sum(float v) {
#pragma unroll
    for (int o = 1; o < 64; o <<= 1) v += __shfl_xor(v, o);
    return v;
}
__device__ __forceinline__ void tr_item(const float* W, int ldw, int k0, int n0, bf16* WT, int ldt, int drow0, int dcol0, const float* rg, float cs, LAS float* scr, int lane) {
    const int kr = lane >> 3, nc = 4 * (lane & 7);
    f32x4 v[8]; float sc[8];
#pragma unroll
    for (int i = 0; i < 8; ++i) v[i] = __builtin_nontemporal_load((const GAS f32x4*)(W + (size_t)(k0 + 8 * i + kr) * ldw + n0 + nc));
#pragma unroll
    for (int i = 0; i < 8; ++i) sc[i] = rg ? rg[k0 + 8 * i + kr] * cs : cs;
#pragma unroll
    for (int i = 0; i < 8; ++i) { LAS float* d = scr + (8 * i + kr) * 33 + nc; const f32x4 t = v[i] * sc[i]; d[0] = t.x; d[1] = t.y; d[2] = t.z; d[3] = t.w; }
    LDS_WAIT(); asm volatile("" ::: "memory");
    const int c = lane & 7;
#pragma unroll
    for (int j = 0; j < 4; ++j) { const int n = (lane >> 3) + 8 * j; const LAS float* s = scr + (8 * c) * 33 + n;
        v4u o; o.x = pk2(s[0 * 33], s[1 * 33]); o.y = pk2(s[2 * 33], s[3 * 33]); o.z = pk2(s[4 * 33], s[5 * 33]); o.w = pk2(s[6 * 33], s[7 * 33]);
        *(GAS v4u*)(WT + (size_t)(drow0 + n) * ldt + dcol0 + 8 * c) = o; }
    LDS_WAIT(); asm volatile("" ::: "memory");
}
__device__ __forceinline__ void tr_item_q(const float* W, int ldw, int k0, int n0, unsigned char* WT, int ldt, int drow0, int dcol0, const float* rg, float cs, LAS float* scr, int lane) {
    const int kr = lane >> 3, nc = 4 * (lane & 7);
    f32x4 v[8]; float sc[8];
#pragma unroll
    for (int i = 0; i < 8; ++i) v[i] = __builtin_nontemporal_load((const GAS f32x4*)(W + (size_t)(k0 + 8 * i + kr) * ldw + n0 + nc));
#pragma unroll
    for (int i = 0; i < 8; ++i) sc[i] = rg ? rg[k0 + 8 * i + kr] * cs : cs;
#pragma unroll
    for (int i = 0; i < 8; ++i) { LAS float* d = scr + (8 * i + kr) * 33 + nc; const f32x4 t = v[i] * sc[i]; d[0] = t.x; d[1] = t.y; d[2] = t.z; d[3] = t.w; }
    LDS_WAIT(); asm volatile("" ::: "memory");
    const int c = lane & 7;
#pragma unroll
    for (int j = 0; j < 4; ++j) { const int n = (lane >> 3) + 8 * j; const LAS float* s = scr + (8 * c) * 33 + n;
        const f32x4 a = {s[0 * 33], s[1 * 33], s[2 * 33], s[3 * 33]}, b = {s[4 * 33], s[5 * 33], s[6 * 33], s[7 * 33]};
        *(GAS pg8::u32x2*)(WT + (size_t)(drow0 + n) * ldt + dcol0 + 8 * c) = pg8::pack8_fp8(a, b); }
    LDS_WAIT(); asm volatile("" ::: "memory");
}
__device__ __forceinline__ unsigned pack4_i8(float a, float b, float c, float d) {
    const int q0 = (int)__builtin_rintf(fminf(fmaxf(a, -127.f), 127.f)), q1 = (int)__builtin_rintf(fminf(fmaxf(b, -127.f), 127.f)), q2 = (int)__builtin_rintf(fminf(fmaxf(c, -127.f), 127.f)), q3 = (int)__builtin_rintf(fminf(fmaxf(d, -127.f), 127.f));
    return (unsigned)(q0 & 255) | ((unsigned)(q1 & 255) << 8) | ((unsigned)(q2 & 255) << 16) | ((unsigned)q3 << 24);
}
__device__ __forceinline__ void tr_item_i8(const float* W, int ldw, int k0, int n0, unsigned char* WT, int ldt, int drow0, int dcol0, const float* rg, float cs, LAS float* scr, int lane) {
    const int kr = lane >> 3, nc = 4 * (lane & 7);
    f32x4 v[8]; float sc[8];
#pragma unroll
    for (int i = 0; i < 8; ++i) v[i] = __builtin_nontemporal_load((const GAS f32x4*)(W + (size_t)(k0 + 8 * i + kr) * ldw + n0 + nc));
#pragma unroll
    for (int i = 0; i < 8; ++i) sc[i] = rg ? rg[k0 + 8 * i + kr] * cs : cs;
#pragma unroll
    for (int i = 0; i < 8; ++i) { LAS float* d = scr + (8 * i + kr) * 33 + nc; const f32x4 t = v[i] * sc[i]; d[0] = t.x; d[1] = t.y; d[2] = t.z; d[3] = t.w; }
    LDS_WAIT(); asm volatile("" ::: "memory");
    const int c = lane & 7;
#pragma unroll
    for (int j = 0; j < 4; ++j) { const int n = (lane >> 3) + 8 * j; const LAS float* s = scr + (8 * c) * 33 + n;
        v2u o; o.x = pack4_i8(s[0 * 33], s[1 * 33], s[2 * 33], s[3 * 33]); o.y = pack4_i8(s[4 * 33], s[5 * 33], s[6 * 33], s[7 * 33]);
        *(GAS v2u*)(WT + (size_t)(drow0 + n) * ldt + dcol0 + 8 * c) = o; }
    LDS_WAIT(); asm volatile("" ::: "memory");
}
__device__ __forceinline__ int win_dst(int n) {
    if (n < 256) return n;
    if (n < 512) return PC_Q1 + (n - 256);
    if (n < 768) return PC_Q2 + (n - 512);
    if (n < 1536) { const int c = n - 768; return PC_K + (c >> 6) * 128 + (c & 63); }
    if (n < 2304) { const int c = n - 1536; return PC_K + (c >> 6) * 128 + 64 + (c & 63); }
    if (n < 3072) return PC_BG + (n - 2304);
    if (n < 3840) { const int i = (n - 3072) >> 7, w = (n - 3072) & 127; return 3072 + 256 * i + w; }
    if (n < 4608) { const int i = (n - 3840) >> 7, w = (n - 3840) & 127; return 3072 + 256 * i + 128 + w; }
    return n;
}
__device__ __forceinline__ void p0_prologue(Frame& F) {
    LAS float* scr = (LAS float*)(F.lds + F.wave * 16384);
    const int gw = F.vcu * NWAVES + F.wave, NGW = F.G * NWAVES;
    constexpr int I_IN = (D / 64) * (NPROJ / 32), I_AO = (256 / 64) * (D / 32), I_CO = (768 / 64) * (D / 32), I_O = (D / 64) * (D / 32);
    constexpr int NITEMS = I_IN + I_AO + I_CO + I_O;
    for (int it = gw; it < NITEMS; it += NGW) {
        int r = it;
        if (r < I_IN) { const int nb = r % (NPROJ / 32), kb = r / (NPROJ / 32); const int n0 = 32 * nb;
            tr_item_i8(F.w_in, NPROJ, 64 * kb, n0, (unsigned char*)F.WinT, D, win_dst(n0), 64 * kb, F.g_mix, 127.0f / W8_CLIP, scr, F.lane);
            continue; }
        r -= I_IN;
        if (r < I_AO) { const int nb = r % (D / 32), kb = r / (D / 32); tr_item(F.w_ao, D, 64 * kb, 32 * nb, F.WacT, D, 32 * nb, 64 * kb, nullptr, 1.0f, scr, F.lane); continue; }
        r -= I_AO;
        if (r < I_CO) { const int nb = r % (D / 32), kb = r / (D / 32); tr_item(F.w_co, D, 64 * kb, 32 * nb, F.WacT, D, 32 * nb, 256 + 64 * kb, nullptr, 1.0f, scr, F.lane); continue; }
        r -= I_CO;
        { const int nb = r % (D / 32), kb = r / (D / 32); tr_item(F.w_out, D, 64 * kb, 32 * nb, F.WoT, D, 32 * nb, 64 * kb, nullptr, 1.0f, scr, F.lane); }
    }
    for (int idx = gw * 64 + F.lane; idx < 48 * D / 2; idx += NGW * 64) { const int c = idx >> 9, k = (idx & (D / 2 - 1)) * 2;
        float w0 = 0.f, w1 = 0.f; if (c < 4) { w0 = F.w_rg[k * 4 + c]; w1 = F.w_rg[(k + 1) * 4 + c]; } else if (c < 36) { w0 = F.w_re[k * 32 + (c - 4)]; w1 = F.w_re[(k + 1) * 32 + (c - 4)]; }
        ((unsigned*)F.WrT)[idx] = pk2(w0 * F.g_ffn[k], w1 * F.g_ffn[k + 1]); }
    for (int m4 = gw * 4; m4 < T; m4 += NGW * 4) {
        f32x4 v[4][4]; float sq[4];
#pragma unroll
        for (int q = 0; q < 4; ++q) { const GAS f32x4* xr = (const GAS f32x4*)(F.x + (size_t)(m4 + q) * D) + F.lane;
#pragma unroll
            for (int j = 0; j < 4; ++j) v[q][j] = __builtin_nontemporal_load(xr + 64 * j); }
#pragma unroll
        for (int q = 0; q < 4; ++q) { float s = 0.f;
#pragma unroll
            for (int j = 0; j < 4; ++j) s += (v[q][j].x * v[q][j].x + v[q][j].y * v[q][j].y) + (v[q][j].z * v[q][j].z + v[q][j].w * v[q][j].w);
            sq[q] = s; }
#pragma unroll
        for (int o = 1; o < 64; o <<= 1) {
#pragma unroll
            for (int q = 0; q < 4; ++q) sq[q] += __shfl_xor(sq[q], o); }
        float mx[4];
#pragma unroll
        for (int q = 0; q < 4; ++q) { float m_ = 0.f;
#pragma unroll
            for (int j = 0; j < 4; ++j) m_ = fmaxf(fmaxf(fmaxf(fabsf(v[q][j].x), fabsf(v[q][j].y)), fmaxf(fabsf(v[q][j].z), fabsf(v[q][j].w))), m_);
            mx[q] = m_; }
#pragma unroll
        for (int o = 1; o < 64; o <<= 1) {
#pragma unroll
            for (int q = 0; q < 4; ++q) mx[q] = fmaxf(mx[q], __shfl_xor(mx[q], o)); }
#pragma unroll
        for (int q = 0; q < 4; ++q) { const float rstd = 1.0f / sqrtf(sq[q] * (1.f / D) + RMS_EPS);
            const float amax = fmaxf(mx[q] * rstd, 1e-20f), sxv = amax * (1.0f / 127.0f), qs = rstd * (127.0f / amax);
            if (F.lane == 0) F.irs1[m4 + q] = sxv;
            GAS unsigned* o4 = (GAS unsigned*)(F.XNQ + (size_t)(m4 + q) * D) + F.lane;
#pragma unroll
            for (int j = 0; j < 4; ++j) o4[64 * j] = pack4_i8(v[q][j].x * qs, v[q][j].y * qs, v[q][j].z * qs, v[q][j].w * qs); }
    }
}

__device__ __forceinline__ void p2_conv(Frame& F, bf16* dummy = nullptr) {
    const int gw = F.vcu * NWAVES + F.wave, NGW = F.G * NWAVES;
    for (int t4 = gw * 4; t4 < T; t4 += NGW * 4) {
        const int s0 = t4 & (SEQ - 1);
#pragma unroll
        for (int it = 0; it < 3; ++it) { const int ch = 4 * F.lane + 256 * it;
            const bf16* up = F.PROJ + (size_t)t4 * PROJ_LD + PC_U + ch; bf16* bp = F.PROJ + (size_t)t4 * PROJ_LD + PC_BG + ch;
            v2u u[6], bg[4];
#pragma unroll
            for (int q = 0; q < 6; ++q) { const int sq = s0 - 1 + q; u[q] = (v2u){0u, 0u}; if (sq >= 0 && sq < SEQ) u[q] = *(const GAS v2u*)(up + (q - 1) * PROJ_LD); }
#pragma unroll
            for (int q = 0; q < 4; ++q) bg[q] = *(const GAS v2u*)(bp + q * PROJ_LD);
            const f32x4 w0 = *(const GAS f32x4*)(F.conv_w + ch), w1 = *(const GAS f32x4*)(F.conv_w + 768 + ch), w2 = *(const GAS f32x4*)(F.conv_w + 1536 + ch);
#pragma unroll
            for (int q = 0; q < 4; ++q) { const v2u um = u[q], u0 = u[q + 1], upl = u[q + 2];
                const float c0 = bflo(bg[q].x) * (w0.x * bflo(um.x) + w1.x * bflo(u0.x) + w2.x * bflo(upl.x));
                const float c1 = bfhi(bg[q].x) * (w0.y * bfhi(um.x) + w1.y * bfhi(u0.x) + w2.y * bfhi(upl.x));
                const float c2 = bflo(bg[q].y) * (w0.z * bflo(um.y) + w1.z * bflo(u0.y) + w2.z * bflo(upl.y));
                const float c3 = bfhi(bg[q].y) * (w0.w * bfhi(um.y) + w1.w * bfhi(u0.y) + w2.w * bfhi(upl.y));
                v2u o; o.x = pk2(c0, c1); o.y = pk2(c2, c3); bf16* dp = dummy ? dummy + (size_t)(t4 + q) * 768 + ch : bp + q * PROJ_LD; *(GAS v2u*)dp = o; } }
    }
}
__device__ __forceinline__ void p2_attn_naive(Frame& F) {
    for (int blk = F.vcu; blk < T / 128; blk += F.G) {
        const int t = blk * 128 + (F.tid & 127), j = F.tid >> 7;
        const int b = t / SEQ, s = t % SEQ;
        float o[64];
#pragma unroll
        for (int e = 0; e < 64; ++e) o[e] = 0.f;
        float mx = -1e30f, l = 0.f;
        for (int g = 0; g < 3; ++g) {
            const int dil = g == 0 ? 1 : (g == 1 ? 4 : 16);
            const int qc = (g == 0 ? PC_Q0 : (g == 1 ? PC_Q1 : PC_Q2)) + 64 * j;
            const float slope2 = exp2f(-8.0f * (float)(4 * g + j + 1) / 12.0f) * LOG2E * (float)dil;
            float q[64];
            { const bf16* qp = F.PROJ + (size_t)t * PROJ_LD + qc;
#pragma unroll
              for (int c = 0; c < 8; ++c) { const v4u w = *(const GAS v4u*)(qp + 8 * c);
#pragma unroll
                  for (int z = 0; z < 4; ++z) { q[8 * c + 2 * z] = bflo(w[z]); q[8 * c + 2 * z + 1] = bfhi(w[z]); } } }
            for (int dl = -64; dl <= 64; ++dl) {
                const int s2 = s + dl * dil;
                if (s2 < 0 || s2 >= SEQ) continue;
                const bf16* kp = F.PROJ + (size_t)(b * SEQ + s2) * PROJ_LD + PC_K + g * 256 + 64 * j;
                float dot = 0.f;
#pragma unroll
                for (int c = 0; c < 8; ++c) { const v4u w = *(const GAS v4u*)(kp + 8 * c);
#pragma unroll
                    for (int z = 0; z < 4; ++z) dot += q[8 * c + 2 * z] * bflo(w[z]) + q[8 * c + 2 * z + 1] * bfhi(w[z]); }
                const float sc = dot - slope2 * (float)(dl < 0 ? -dl : dl);
                const float mn = fmaxf(mx, sc);
                const float alpha = fast_exp2(mx - mn), p = fast_exp2(sc - mn);
                mx = mn; l = l * alpha + p;
                const bf16* vp = kp + (PC_V - PC_K);
#pragma unroll
                for (int c = 0; c < 8; ++c) { const v4u w = *(const GAS v4u*)(vp + 8 * c);
#pragma unroll
                    for (int z = 0; z < 4; ++z) { o[8 * c + 2 * z] = o[8 * c + 2 * z] * alpha + p * bflo(w[z]); o[8 * c + 2 * z + 1] = o[8 * c + 2 * z + 1] * alpha + p * bfhi(w[z]); } }
            }
        }
        const float inv = 1.0f / l;
        bf16* op = F.PROJ + (size_t)t * PROJ_LD + PC_O + 64 * j;
#pragma unroll
        for (int c = 0; c < 8; ++c) { v4u w;
#pragma unroll
            for (int z = 0; z < 4; ++z) w[z] = pk2(o[8 * c + 2 * z] * inv, o[8 * c + 2 * z + 1] * inv);
            *(GAS v4u*)(op + 8 * c) = w; }
    }
}


typedef float f32x16 __attribute__((ext_vector_type(16)));
typedef short bf16x8v __attribute__((ext_vector_type(8)));
typedef short s16x4 __attribute__((ext_vector_type(4)));
typedef short v4i16_t __attribute__((ext_vector_type(4)));
__device__ __forceinline__ int crow(int r, int hi) { return (r & 3) + 8 * (r >> 2) + 4 * hi; }
__device__ __forceinline__ s16x4 tr_read(const LAS unsigned char* p) { return __builtin_bit_cast(s16x4, __builtin_amdgcn_ds_read_tr16_b64_v4i16((LAS v4i16_t*)p)); }
__device__ __forceinline__ void attn_unit(Frame& F, int u, LAS unsigned char* vl, float* lse) {
    const int lane = F.lane, r32 = lane & 31, hi = lane >> 5;
    const int g = u >> 12, rem = u & 4095, j = rem >> 10, st = rem & 1023;
    const int sh = 2 * g, dil = 1 << sh, L = SEQ >> sh;
    const int b = st >> 8, w = st & 255, r = w >> (8 - sh), ti = w & ((256 >> sh) - 1);
    const int i0 = 32 * ti;
    const size_t rowbase = (size_t)b * SEQ + r;
    const int qcol = (g == 0 ? PC_Q0 : (g == 1 ? PC_Q1 : PC_Q2)) + 64 * j;
    const bf16* kbase = F.PROJ + PC_K + g * 256 + 64 * j;
    const float slope2 = exp2f(-8.0f * (float)(4 * g + j + 1) / 12.0f) * LOG2E * (float)dil;
    const size_t qrow = rowbase + (size_t)(i0 + r32) * dil;
    bf16x8v qr[4];
    { const bf16* qp = F.PROJ + qrow * PROJ_LD + qcol + 8 * hi;
#pragma unroll
      for (int d0 = 0; d0 < 4; ++d0) qr[d0] = *(const GAS bf16x8v*)(qp + 16 * d0); }
    f32x16 p[5];
#pragma unroll
    for (int kt = 0; kt < 5; ++kt) {
        int pos = i0 - 64 + 32 * kt + r32; pos = pos < 0 ? 0 : (pos > L - 1 ? L - 1 : pos);
        const bf16* kp = kbase + (rowbase + (size_t)pos * dil) * PROJ_LD + 8 * hi;
        bf16x8v kf[4];
#pragma unroll
        for (int d0 = 0; d0 < 4; ++d0) kf[d0] = *(const GAS bf16x8v*)(kp + 16 * d0);
        f32x16 a = {0.f, 0.f, 0.f, 0.f, 0.f, 0.f, 0.f, 0.f, 0.f, 0.f, 0.f, 0.f, 0.f, 0.f, 0.f, 0.f};
#pragma unroll
        for (int d0 = 0; d0 < 4; ++d0) a = __builtin_amdgcn_mfma_f32_32x32x16_bf16(kf[d0], qr[d0], a, 0, 0, 0);
        p[kt] = a;
    }
    float mloc = -1e30f;
    const float dbase = (float)(4 * hi - r32 - 64);
#pragma unroll
    for (int kt = 0; kt < 5; ++kt)
#pragma unroll
        for (int rr = 0; rr < 16; ++rr) {
            const float d = dbase + (float)(32 * kt + (rr & 3) + 8 * (rr >> 2));
            float sv = p[kt][rr] - slope2 * fabsf(d);
            if (kt == 0) sv = d >= -64.0f ? sv : -1e30f;
            if (kt == 4) sv = d <= 64.0f ? sv : -1e30f;
            p[kt][rr] = sv;
        }
    if (i0 < 64 || i0 + 96 > L) {
#pragma unroll
        for (int kt = 0; kt < 5; ++kt)
#pragma unroll
            for (int rr = 0; rr < 16; ++rr) { const int pos = i0 - 64 + 32 * kt + crow(rr, hi); p[kt][rr] = (pos >= 0 && pos < L) ? p[kt][rr] : -1e30f; }
    }
#pragma unroll
    for (int kt = 0; kt < 5; ++kt)
#pragma unroll
        for (int rr = 0; rr < 16; ++rr) mloc = fmaxf(mloc, p[kt][rr]);
    const float mrow = fmaxf(mloc, __shfl_xor(mloc, 32));
    float lsum = 0.f;
#pragma unroll
    for (int kt = 0; kt < 5; ++kt)
#pragma unroll
        for (int rr = 0; rr < 16; ++rr) { const float e = fast_exp2(p[kt][rr] - mrow); p[kt][rr] = e; lsum += e; }
    const float lrow = lsum + __shfl_xor(lsum, 32);
    bf16x8v pb[5][2];
#pragma unroll
    for (int kt = 0; kt < 5; ++kt)
#pragma unroll
        for (int s2 = 0; s2 < 2; ++s2) { v4u wv;
#pragma unroll
            for (int q = 0; q < 4; ++q) wv[q] = pg8::cvt_pk_bf16(p[kt][8 * s2 + 2 * q], p[kt][8 * s2 + 2 * q + 1]);
            pb[kt][s2] = __builtin_bit_cast(bf16x8v, wv); }
    f32x16 o[2];
#pragma unroll
    for (int db = 0; db < 2; ++db) o[db] = (f32x16){0.f, 0.f, 0.f, 0.f, 0.f, 0.f, 0.f, 0.f, 0.f, 0.f, 0.f, 0.f, 0.f, 0.f, 0.f, 0.f};
    const bf16* vbase = kbase + (PC_V - PC_K);
    const LAS unsigned char* vrd = vl + (4 * hi + ((lane & 15) >> 2)) * 128 + ((lane >> 4) & 1) * 32 + (lane & 3) * 8;
#pragma unroll
    for (int kt = 0; kt < 5; ++kt) {
        v4u vv[4];
#pragma unroll
        for (int i = 0; i < 4; ++i) { int pos = i0 - 64 + 32 * kt + 8 * i + (lane >> 3); pos = pos < 0 ? 0 : (pos > L - 1 ? L - 1 : pos);
            vv[i] = *(const GAS v4u*)(vbase + (rowbase + (size_t)pos * dil) * PROJ_LD + 8 * (lane & 7)); }
        asm volatile("" ::: "memory");
#pragma unroll
        for (int i = 0; i < 4; ++i) *(LAS v4u*)(vl + (8 * i + (lane >> 3)) * 128 + (lane & 7) * 16) = vv[i];
        asm volatile("" ::: "memory");
#pragma unroll
        for (int db = 0; db < 2; ++db)
#pragma unroll
            for (int s2 = 0; s2 < 2; ++s2) {
                const s16x4 lo = tr_read(vrd + (16 * s2) * 128 + db * 64), hh = tr_read(vrd + (16 * s2 + 8) * 128 + db * 64);
                const bf16x8v vf = (bf16x8v){lo[0], lo[1], lo[2], lo[3], hh[0], hh[1], hh[2], hh[3]};
                o[db] = __builtin_amdgcn_mfma_f32_32x32x16_bf16(vf, pb[kt][s2], o[db], 0, 0, 0);
            }
        asm volatile("" ::: "memory");
    }
    const float inv = 1.0f / lrow;
    bf16* op = F.X1B + qrow * 768 + g * 256 + 64 * j + 4 * hi;
#pragma unroll
    for (int db = 0; db < 2; ++db)
#pragma unroll
        for (int rg = 0; rg < 4; ++rg) { v2u wv; wv.x = pg8::cvt_pk_bf16(o[db][4 * rg] * inv, o[db][4 * rg + 1] * inv); wv.y = pg8::cvt_pk_bf16(o[db][4 * rg + 2] * inv, o[db][4 * rg + 3] * inv);
            *(GAS v2u*)(op + 32 * db + 8 * rg) = wv; }
    if (hi == 0) lse[qrow * 12 + g * 4 + j] = mrow + log2f(lrow);
}
struct AttnItem { int g, j, sh, L, c0; size_t rowbase; };
__device__ __forceinline__ AttnItem attn_decode(int it) {
    AttnItem a; a.g = it >> 9; const int rem = it & 511; a.j = rem >> 7; const int sq = rem & 127; const int b = sq >> 5, w = sq & 31;
    a.sh = 2 * a.g; a.L = SEQ >> a.sh; const int r = w >> (5 - a.sh), ci = w & ((32 >> a.sh) - 1); a.c0 = 256 * ci; a.rowbase = (size_t)b * SEQ + r; return a;
}
__device__ __forceinline__ void attn_fetch(Frame& F, const AttnItem& a, v4u (&R)[6]) {
    const unsigned char* base = (const unsigned char*)(F.PROJ + PC_K) + (a.g * 4 + a.j) * 128;
    int tid = F.tid; asm volatile("" : "+v"(tid));
#pragma unroll
    for (int k = 0; k < 6; ++k) { const int id = tid + 512 * k, row = id >> 3, c8 = id & 7;
        int pos = a.c0 - 64 + row; pos = pos < 0 ? 0 : (pos > a.L - 1 ? a.L - 1 : pos);
        R[k] = *(const GAS v4u*)(base + (a.rowbase + ((size_t)pos << a.sh)) * (size_t)(PROJ_LD * 2) + 16 * c8); }
}
__device__ __forceinline__ void attn_commit(Frame& F, const v4u (&R)[6], LAS unsigned char* kimg, LAS unsigned char* vimg) {
    int tid = F.tid; asm volatile("" : "+v"(tid));
#pragma unroll
    for (int k = 0; k < 6; ++k) { const int id = tid + 512 * k, row = id >> 3, c8 = id & 7, c4 = c8 & 3;
        unsigned w[8];
#pragma unroll
        for (int q = 0; q < 4; ++q) { const pg8::f32x2_t lo = __builtin_amdgcn_cvt_pk_f32_fp8((int)R[k][q], false), hi = __builtin_amdgcn_cvt_pk_f32_fp8((int)R[k][q], true);
            w[2 * q] = pg8::cvt_pk_bf16(lo[0], lo[1]); w[2 * q + 1] = pg8::cvt_pk_bf16(hi[0], hi[1]); }
        const int sw = ((row & 2) << 1) | ((row >> 2) & 3);
        LAS unsigned char* img = ((c8 & 4) ? vimg : kimg) + row * 128;
        *(LAS v4u*)(img + (((2 * c4) ^ sw) << 4)) = (v4u){w[0], w[1], w[2], w[3]};
        *(LAS v4u*)(img + (((2 * c4 + 1) ^ sw) << 4)) = (v4u){w[4], w[5], w[6], w[7]}; }
}
__device__ __forceinline__ void p2_attn_v2(Frame& F) {
    LAS unsigned char* kimg = F.lds; LAS unsigned char* vimg = F.lds + 49152;
    float* lse = (float*)F.list;
    const int lane = F.lane, r32 = lane & 31, hi = lane >> 5, w = F.wave;
    const int swk = ((r32 & 2) << 1) | ((r32 >> 2) & 3);
    const LAS unsigned char* kb = kimg + (32 * w + r32) * 128;
    int koff[4];
#pragma unroll
    for (int d0 = 0; d0 < 4; ++d0) koff[d0] = ((2 * d0 + hi) ^ swk) << 4;
    const int qp_ = (lane & 15) >> 2, pp_ = lane & 3, gh = (lane >> 4) & 1;
    const LAS unsigned char* vad[2][2];
#pragma unroll
    for (int a = 0; a < 2; ++a)
#pragma unroll
        for (int db = 0; db < 2; ++db) { const int sw = ((qp_ & 2) << 1) | ((2 * a + hi) & 3); const int cb = 4 * db + 2 * gh + (pp_ >> 1);
            vad[a][db] = vimg + (32 * w + 8 * a + 4 * hi + qp_) * 128 + ((cb ^ sw) << 4) + (pp_ & 1) * 8; }
    int it = F.vcu;
    v4u R[6];
    bf16x8v qr[4];
#define ATTN_LOAD_Q(item) do { const AttnItem aq_ = attn_decode(item); const int qcol_ = (aq_.g == 0 ? PC_Q0 : (aq_.g == 1 ? PC_Q1 : PC_Q2)) + 64 * aq_.j; \
        const bf16* qp_g = F.PROJ + (aq_.rowbase + ((size_t)(aq_.c0 + 32 * w + r32) << aq_.sh)) * PROJ_LD + qcol_ + 8 * hi; \
        _Pragma("unroll") for (int d0 = 0; d0 < 4; ++d0) qr[d0] = *(const GAS bf16x8v*)(qp_g + 16 * d0); } while (0)
    if (it < 1536) { const AttnItem a0 = attn_decode(it); attn_fetch(F, a0, R); ATTN_LOAD_Q(it); }
    for (; it < 1536; it += F.G) {
        const AttnItem a = attn_decode(it);
        const int dil = 1 << a.sh, L = a.L, i0 = a.c0 + 32 * w;
        const float slope2 = exp2f(-8.0f * (float)(4 * a.g + a.j + 1) / 12.0f) * LOG2E * (float)dil;
        const size_t qrow = a.rowbase + (size_t)(i0 + r32) * dil;
        attn_commit(F, R, kimg, vimg);
        asm volatile("s_waitcnt lgkmcnt(0)" ::: "memory");
        __builtin_amdgcn_s_barrier(); asm volatile("" ::: "memory");
        if (it + F.G < 1536) { const AttnItem an = attn_decode(it + F.G); attn_fetch(F, an, R); }
        f32x16 p[5];
#pragma unroll
        for (int kt = 0; kt < 5; ++kt) {
            bf16x8v kf[4];
#pragma unroll
            for (int d0 = 0; d0 < 4; ++d0) kf[d0] = *(const LAS bf16x8v*)(kb + kt * 4096 + koff[d0]);
            f32x16 acc = {0.f, 0.f, 0.f, 0.f, 0.f, 0.f, 0.f, 0.f, 0.f, 0.f, 0.f, 0.f, 0.f, 0.f, 0.f, 0.f};
#pragma unroll
            for (int d0 = 0; d0 < 4; ++d0) acc = __builtin_amdgcn_mfma_f32_32x32x16_bf16(kf[d0], qr[d0], acc, 0, 0, 0);
            p[kt] = acc;
        }
        if (it + F.G < 1536) ATTN_LOAD_Q(it + F.G);
        float mloc = -1e30f;
        float dbase = (float)(4 * hi - r32 - 64);
        asm volatile("" : "+v"(dbase));
#pragma unroll
        for (int kt = 0; kt < 5; ++kt)
#pragma unroll
            for (int rr = 0; rr < 16; ++rr) {
                const float d = dbase + (float)(32 * kt + (rr & 3) + 8 * (rr >> 2));
                float sv = p[kt][rr] - slope2 * fabsf(d);
                if (kt == 0) sv = d >= -64.0f ? sv : -1e30f;
                if (kt == 4) sv = d <= 64.0f ? sv : -1e30f;
                p[kt][rr] = sv;
            }
        if (i0 < 64 || i0 + 96 > L) {
#pragma unroll
            for (int kt = 0; kt < 5; ++kt)
#pragma unroll
                for (int rr = 0; rr < 16; ++rr) { const int pos = i0 - 64 + 32 * kt + crow(rr, hi); p[kt][rr] = (pos >= 0 && pos < L) ? p[kt][rr] : -1e30f; }
        }
#pragma unroll
        for (int kt = 0; kt < 5; ++kt)
#pragma unroll
            for (int rr = 0; rr < 16; ++rr) mloc = fmaxf(mloc, p[kt][rr]);
        const float mrow = fmaxf(mloc, __shfl_xor(mloc, 32));
        float lsum = 0.f;
#pragma unroll
        for (int kt = 0; kt < 5; ++kt)
#pragma unroll
            for (int rr = 0; rr < 16; ++rr) { const float e = fast_exp2(p[kt][rr] - mrow); p[kt][rr] = e; lsum += e; }
        const float lrow = lsum + __shfl_xor(lsum, 32);
        bf16x8v pb[5][2];
#pragma unroll
        for (int kt = 0; kt < 5; ++kt)
#pragma unroll
            for (int s2 = 0; s2 < 2; ++s2) { v4u wv;
#pragma unroll
                for (int q = 0; q < 4; ++q) wv[q] = pg8::cvt_pk_bf16(p[kt][8 * s2 + 2 * q], p[kt][8 * s2 + 2 * q + 1]);
                pb[kt][s2] = __builtin_bit_cast(bf16x8v, wv); }
        f32x16 o[2];
#pragma unroll
        for (int db = 0; db < 2; ++db) o[db] = (f32x16){0.f, 0.f, 0.f, 0.f, 0.f, 0.f, 0.f, 0.f, 0.f, 0.f, 0.f, 0.f, 0.f, 0.f, 0.f, 0.f};
#pragma unroll
        for (int kt = 0; kt < 5; ++kt)
#pragma unroll
            for (int db = 0; db < 2; ++db)
#pragma unroll
                for (int s2 = 0; s2 < 2; ++s2) {
                    const s16x4 lo = tr_read(vad[0][db] + kt * 4096 + s2 * 2048), hh = tr_read(vad[1][db] + kt * 4096 + s2 * 2048);
                    const bf16x8v vf = (bf16x8v){lo[0], lo[1], lo[2], lo[3], hh[0], hh[1], hh[2], hh[3]};
                    o[db] = __builtin_amdgcn_mfma_f32_32x32x16_bf16(vf, pb[kt][s2], o[db], 0, 0, 0);
                }
        const float inv = 1.0f / lrow;
        bf16* op = F.X1B + qrow * 768 + a.g * 256 + 64 * a.j + 4 * hi;
#pragma unroll
        for (int db = 0; db < 2; ++db)
#pragma unroll
            for (int rg = 0; rg < 4; ++rg) { v2u wv; wv.x = pg8::cvt_pk_bf16(o[db][4 * rg] * inv, o[db][4 * rg + 1] * inv); wv.y = pg8::cvt_pk_bf16(o[db][4 * rg + 2] * inv, o[db][4 * rg + 3] * inv);
                *(GAS v2u*)(op + 32 * db + 8 * rg) = wv; }
        if (hi == 0) lse[qrow * 12 + a.g * 4 + a.j] = mrow + log2f(lrow);
        asm volatile("s_waitcnt lgkmcnt(0)" ::: "memory");
        __builtin_amdgcn_s_barrier(); asm volatile("" ::: "memory");
    }
#undef ATTN_LOAD_Q
    asm volatile("s_waitcnt vmcnt(0)" ::: "memory");
    __syncthreads();
}
__device__ __forceinline__ void p2_attn_mfma(Frame& F) {
    LAS unsigned char* vl = F.lds + F.wave * 4096;
    float* lse = (float*)F.list;
    const int gw = F.vcu * NWAVES + F.wave, NGW = F.G * NWAVES;
    for (int rep_ = 0; rep_ < 1 + ((REPEAT_MASK >> 2) & 1); ++rep_)
    for (int u = gw; u < 3 * 4096; u += NGW) attn_unit(F, u, vl, lse);
}
__device__ __forceinline__ void p3_merge(Frame& F) {
    const float* lse = (const float*)F.list;
    const int gw = F.vcu * NWAVES + F.wave, NGW = F.G * NWAVES;
    const int j = F.lane >> 4;
    for (int t4 = gw * 4; t4 < T; t4 += NGW * 4) {
        float l[4][3]; v2u p[4][3];
#pragma unroll
        for (int q = 0; q < 4; ++q) { const float* lp = lse + (size_t)(t4 + q) * 12 + j; const bf16* pp = F.X1B + (size_t)(t4 + q) * 768 + 4 * F.lane;
#pragma unroll
            for (int g = 0; g < 3; ++g) { l[q][g] = lp[4 * g]; p[q][g] = *(const GAS v2u*)(pp + 256 * g); } }
#pragma unroll
        for (int q = 0; q < 4; ++q) {
            const float mx = fmaxf(l[q][0], fmaxf(l[q][1], l[q][2]));
            const float e0 = fast_exp2(l[q][0] - mx), e1 = fast_exp2(l[q][1] - mx), e2 = fast_exp2(l[q][2] - mx);
            const float inv = 1.0f / (e0 + e1 + e2);
            const float w0 = e0 * inv, w1 = e1 * inv, w2 = e2 * inv;
            const v2u a = p[q][0], b = p[q][1], c = p[q][2];
            v2u o; o.x = pk2(w0 * bflo(a.x) + w1 * bflo(b.x) + w2 * bflo(c.x), w0 * bfhi(a.x) + w1 * bfhi(b.x) + w2 * bfhi(c.x));
            o.y = pk2(w0 * bflo(a.y) + w1 * bflo(b.y) + w2 * bflo(c.y), w0 * bfhi(a.y) + w1 * bfhi(b.y) + w2 * bfhi(c.y));
            *(GAS v2u*)(F.PROJ + (size_t)(t4 + q) * PROJ_LD + 4 * F.lane + PC_O) = o;
        }
    }
}

__device__ __forceinline__ void p5_route(Frame& F) {
    LAS float* scr = (LAS float*)(F.lds + F.wave * 16384);
    const int gw = F.vcu * NWAVES + F.wave, NGW = F.G * NWAVES;
    {
        constexpr int PER_E = 256 * 2;
        for (int rep_ = 0; rep_ < 1 + ((REPEAT_MASK >> 6) & 1); ++rep_)
        for (int it = gw; it < NEXP * PER_E; it += NGW) {
            const int e = it / PER_E; int r = it % PER_E;
            const int which = r >> 8; r &= 255; const int nb = r & 15, kb = r >> 4; const int n0 = 32 * nb;
            const float* W = (which ? F.w3 : F.w1) + (size_t)e * D * FF;
            tr_item_q(W, FF, 64 * kb, n0, F.W13Q, D, e * 1024 + 256 * (n0 >> 7) + (n0 & 127) + 128 * which, 64 * kb, F.g_ffn, W13_SCALE, scr, F.lane);
        }
    }
    LAS unsigned* hist = (LAS unsigned*)(F.lds + L_HIST);
    LAS unsigned* lbase = (LAS unsigned*)(F.lds + L_LBASE);
    LAS unsigned* rec = (LAS unsigned*)(F.lds + L_REC);
    if (F.tid < 128) rec[F.tid * 8 + 7] = 0xffffffffu;
    __syncthreads();
    {
        constexpr int WROW = 2064, WIMG = 48 * WROW;
        LAS unsigned char* wimg = F.lds;
        for (int q = F.wave; q < 96; q += NWAVES)
            __builtin_amdgcn_global_load_lds((const unsigned*)((const char*)F.WrT + (size_t)(q >> 1) * 2048 + (q & 1) * 1024 + F.lane * 16), (LAS unsigned*)(wimg + (q >> 1) * WROW + (q & 1) * 1024), 16, 0, 0);
        VM_WAIT(); __syncthreads();
        LAS float* lg = (LAS float*)(F.lds + ((WIMG + 255) & ~255) + F.wave * 3328);
        const int row = F.lane & 15, kq = F.lane >> 4;
        for (int tile = gw; tile < T / 16; tile += NGW) {
            const int t0 = tile * 16;
            const bf16* xp = F.X1B + (size_t)(t0 + row) * D + 8 * kq;
            const LAS unsigned char* wp = wimg + row * WROW + 16 * kq;
            pg8::f32x4 a0 = {0.f, 0.f, 0.f, 0.f}, a1 = a0, a2 = a0; float ss = 0.f;
            for (int rep_ = 0; rep_ < 1 + ((REPEAT_MASK >> 11) & 1); ++rep_) {
            asm volatile("" :: "v"(a0), "v"(a1), "v"(a2), "v"(ss));
            a0 = (pg8::f32x4){0.f, 0.f, 0.f, 0.f}; a1 = a0; a2 = a0; ss = 0.f;
#pragma unroll 8
            for (int c = 0; c < 32; ++c) {
                const v4u xr_ = *(const GAS v4u*)(xp + 32 * c);
                const pg8::bf16x8 xa = __builtin_bit_cast(pg8::bf16x8, xr_);
                const pg8::bf16x8 w0 = *(const LAS pg8::bf16x8*)(wp + 64 * c), w1 = *(const LAS pg8::bf16x8*)(wp + 16 * WROW + 64 * c), w2 = *(const LAS pg8::bf16x8*)(wp + 32 * WROW + 64 * c);
#pragma unroll
                for (int z = 0; z < 4; ++z) { const float lo = bflo(xr_[z]), hi_ = bfhi(xr_[z]); ss += lo * lo + hi_ * hi_; }
                a0 = __builtin_amdgcn_mfma_f32_16x16x32_bf16(xa, w0, a0, 0, 0, 0); a1 = __builtin_amdgcn_mfma_f32_16x16x32_bf16(xa, w1, a1, 0, 0, 0); a2 = __builtin_amdgcn_mfma_f32_16x16x32_bf16(xa, w2, a2, 0, 0, 0);
            }
            }
            ss += __shfl_xor(ss, 16); ss += __shfl_xor(ss, 32);
            const float rstd = 1.0f / sqrtf(ss * (1.f / D) + RMS_EPS);
#pragma unroll
            for (int q = 0; q < 4; ++q) { const int tok = 4 * kq + q; lg[tok * 49 + row] = a0[q]; lg[tok * 49 + 16 + row] = a1[q]; lg[tok * 49 + 32 + row] = a2[q]; }
            if (kq == 0) lg[16 * 49 + row] = rstd;
            LDS_WAIT(); asm volatile("" ::: "memory");
            if (F.lane < 16) {
                const int t = t0 + F.lane; const LAS float* lr = lg + F.lane * 49; const float rs = lg[16 * 49 + F.lane];
                float c[4];
#pragma unroll
                for (int q = 0; q < 4; ++q) c[q] = lr[q] * rs + F.b_rg[q];
                int gi = 0; float cm = c[0];
#pragma unroll
                for (int q = 1; q < 4; ++q) if (c[q] > cm) { cm = c[q]; gi = q; }
                float den = 0.f;
#pragma unroll
                for (int q = 0; q < 4; ++q) den += expf(c[q] - cm);
                const float pg = 1.0f / den;
                float f[8];
#pragma unroll
                for (int q = 0; q < 8; ++q) f[q] = lr[4 + 8 * gi + q] * rs + F.b_re[8 * gi + q];
                int i0 = 0; float f0 = f[0];
#pragma unroll
                for (int q = 1; q < 8; ++q) if (f[q] > f0) { f0 = f[q]; i0 = q; }
                int i1 = -1; float f1 = -3.0e38f;
#pragma unroll
                for (int q = 0; q < 8; ++q) if (q != i0 && f[q] > f1) { f1 = f[q]; i1 = q; }
                const float dd = expf(f1 - f0);
                const float w0 = pg / (1.0f + dd), w1 = pg * dd / (1.0f + dd);
                const int e0 = 8 * gi + i0, e1 = 8 * gi + i1;
                const unsigned r0 = __hip_atomic_fetch_add(hist + e0, 1u, __ATOMIC_RELAXED, __HIP_MEMORY_SCOPE_WORKGROUP);
                const unsigned r1 = __hip_atomic_fetch_add(hist + e1, 1u, __ATOMIC_RELAXED, __HIP_MEMORY_SCOPE_WORKGROUP);
                LAS unsigned* rc = rec + (F.wave * 16 + F.lane) * 8;
                rc[0] = (unsigned)e0; rc[1] = r0; rc[2] = __builtin_bit_cast(unsigned, w0); rc[3] = (unsigned)e1; rc[4] = r1; rc[5] = __builtin_bit_cast(unsigned, w1); rc[6] = __builtin_bit_cast(unsigned, rs); rc[7] = (unsigned)t;
            }
            LDS_WAIT(); asm volatile("" ::: "memory");
        }
    }
    __syncthreads();
    if (F.tid < NEXP) { const unsigned hh = hist[F.tid]; lbase[F.tid] = hh ? __hip_atomic_fetch_add((unsigned*)(F.ctl + CW_CNT + 64 * F.tid), hh, RLX_AGENT) : 0u; }
    __syncthreads();
    if (F.tid < 128) {
        const LAS unsigned* rc = rec + F.tid * 8;
        const unsigned t = rc[7];
        if (t != 0xffffffffu) {
            const int e0 = (int)rc[0], e1 = (int)rc[3];
            const int p0 = (int)(lbase[e0] + rc[1]), p1 = (int)(lbase[e1] + rc[4]);
            const float rstd = __builtin_bit_cast(float, rc[6]);
            F.list[(size_t)e0 * CAP + p0] = (int)t; F.wl[(size_t)e0 * CAP + p0] = __builtin_bit_cast(float, rc[2]); F.rsl[(size_t)e0 * CAP + p0] = rstd;
            F.list[(size_t)e1 * CAP + p1] = (int)t; F.wl[(size_t)e1 * CAP + p1] = __builtin_bit_cast(float, rc[5]); F.rsl[(size_t)e1 * CAP + p1] = rstd;
            *((GAS v4i*)F.tokinfo + t) = (v4i){e0, p0, e1, p1};
        }
    }
}

__device__ __forceinline__ void moe_prefix(Frame& F, int& cnt_e, int& excl, int& incl) {
    int c = 0; if (F.lane < NEXP) { c = (int)__hip_atomic_load((unsigned*)(F.ctl + CW_CNT + 64 * F.lane), RLX_AGENT); if (c > CAP) c = CAP; }
    int v = (c + 255) >> 8;
#pragma unroll
    for (int o = 1; o < 32; o <<= 1) { const int t = __shfl_up(v, o); if ((F.lane & 31) >= o) v += t; }
    cnt_e = c; incl = v; excl = v - ((c + 255) >> 8);
}
__device__ __forceinline__ int moe_tables(Frame& F, bool want_gather) {
    LAS int* cntl = (LAS int*)(F.lds + L_CNT);
    LAS int* tpre = (LAS int*)(F.lds + L_TPRE);
    LAS int* nu = (LAS int*)(F.lds + L_NU);
    LAS int* utab = (LAS int*)(F.lds + L_UTAB);
    LAS int* gtab = (LAS int*)(F.lds + L_GTAB);
    if (F.wave == 0) {
        int c, excl, incl; moe_prefix(F, c, excl, incl);
        if (F.lane < NEXP) { cntl[F.lane] = c; tpre[F.lane] = excl; }
        const int total = __shfl(incl, NEXP - 1);
        if (F.lane == 0) tpre[NEXP] = total;
        const int nunits = total * 4; int n = 0;
        for (int i = 0; i < MAXU; ++i) { const int L = i * F.G + F.vcu; if (L >= nunits) break;
            const int rt = L >> 2, pnl = L & 3;
            const unsigned long long hit = __ballot(F.lane < NEXP && excl <= rt && rt < incl);
            const int e = __builtin_ctzll(hit);
            const int ex = __shfl(excl, e), ce = __shfl(c, e);
            const int pos0 = (rt - ex) * 256; int rows = ce - pos0; if (rows > 256) rows = 256;
            if (F.lane == 0) { utab[i * 8 + 0] = rt; utab[i * 8 + 1] = e * 4 + pnl; utab[i * 8 + 2] = e; utab[i * 8 + 3] = pos0; utab[i * 8 + 4] = rows; }
            n = i + 1; }
        if (F.lane == 0) nu[0] = n;
    }
    __syncthreads();
    const int n = nu[0];
    if (want_gather) {
        for (int idx = F.tid; idx < n * 256; idx += NWAVES * 64) { const int i = idx >> 8, r = idx & 255; const int e = utab[i * 8 + 2], pos0 = utab[i * 8 + 3], rows = utab[i * 8 + 4];
            gtab[idx] = r < rows ? F.list[(size_t)e * CAP + pos0 + r] : 0; }
        __syncthreads();
    }
    return __builtin_amdgcn_readfirstlane(n);
}

__device__ __forceinline__ void p7_w2_copy(Frame& F, int n_mine) {
    const LAS int* tpre = (const LAS int*)(F.lds + L_TPRE);
    const int nunits = tpre[NEXP] * 4, full = nunits / F.G, rem = nunits - full * F.G;
    int nidle = F.G - rem, rank = F.vcu - rem;
    if (rem == 0 || nidle < 64) { nidle = F.G; rank = F.vcu; }
    if (rank < 0) return;
    (void)n_mine;
    LAS float* scr = (LAS float*)(F.lds + F.wave * 16384);
    for (int it = rank * NWAVES + F.wave; it < NEXP * 256; it += nidle * NWAVES) {
        const int e = it >> 8, r = it & 255; const int nb = r & 31, kb = r >> 5;
        tr_item_q(F.w2 + (size_t)e * FF * D, D, 64 * kb, 32 * nb, F.W2Q, FF, e * 1024 + 32 * nb, 64 * kb, nullptr, W2_SCALE, scr, F.lane);
    }
}
__device__ __forceinline__ void p8_final(Frame& F) {
    LAS int* cntl = (LAS int*)(F.lds + L_CNT);
    LAS int* tpre = (LAS int*)(F.lds + L_TPRE);
    if (F.wave == 0) { int c, excl, incl; moe_prefix(F, c, excl, incl); if (F.lane < NEXP) { cntl[F.lane] = c; tpre[F.lane] = excl; } if (F.lane == NEXP - 1) tpre[NEXP] = incl; }
    __syncthreads();
    const int gw = F.vcu * NWAVES + F.wave, NGW = F.G * NWAVES;
    f32x4 gf[4];
#pragma unroll
    for (int j = 0; j < 4; ++j) gf[j] = *((const GAS f32x4*)F.g_fin + F.lane + 64 * j);
    v4i ti[4];
    { const int t0 = gw * 4; if (t0 < T) {
#pragma unroll
        for (int q = 0; q < 4; ++q) ti[q] = *((const GAS v4i*)F.tokinfo + t0 + q); } }
    for (int t4 = gw * 4; t4 < T; t4 += NGW * 4) {
        v2u xb[4][4]; unsigned ya[4][4], yb[4][4];
#pragma unroll
        for (int q = 0; q < 4; ++q) { const GAS v2u* xr = (const GAS v2u*)(F.X1B + (size_t)(t4 + q) * D) + F.lane;
#pragma unroll
            for (int j = 0; j < 4; ++j) xb[q][j] = xr[64 * j]; }
#pragma unroll
        for (int q = 0; q < 4; ++q) {
            const size_t s0 = (size_t)tpre[ti[q].x] * 256 + ti[q].y, s1 = (size_t)tpre[ti[q].z] * 256 + ti[q].w;
            const GAS unsigned* y0 = (const GAS unsigned*)(F.Y + s0 * D) + F.lane; const GAS unsigned* y1 = (const GAS unsigned*)(F.Y + s1 * D) + F.lane;
#pragma unroll
            for (int j = 0; j < 4; ++j) { ya[q][j] = y0[64 * j]; yb[q][j] = y1[64 * j]; }
        }
        { const int tn = t4 + NGW * 4; if (tn < T) {
#pragma unroll
            for (int q = 0; q < 4; ++q) ti[q] = *((const GAS v4i*)F.tokinfo + tn + q); } }
        f32x4 z[4][4]; float sq[4];
#pragma unroll
        for (int q = 0; q < 4; ++q) {
#pragma unroll
            for (int j = 0; j < 4; ++j) { const v2u xb_ = xb[q][j]; const f32x4 xv = {bflo(xb_.x), bfhi(xb_.x), bflo(xb_.y), bfhi(xb_.y)}; const unsigned a = ya[q][j], b = yb[q][j];
                const pg8::f32x2_t a01 = __builtin_amdgcn_cvt_pk_f32_fp8((int)a, false), a23 = __builtin_amdgcn_cvt_pk_f32_fp8((int)a, true), b01 = __builtin_amdgcn_cvt_pk_f32_fp8((int)b, false), b23 = __builtin_amdgcn_cvt_pk_f32_fp8((int)b, true);
                z[q][j].x = xv.x + (a01[0] + b01[0]) * (1.0f / Y_SCALE); z[q][j].y = xv.y + (a01[1] + b01[1]) * (1.0f / Y_SCALE); z[q][j].z = xv.z + (a23[0] + b23[0]) * (1.0f / Y_SCALE); z[q][j].w = xv.w + (a23[1] + b23[1]) * (1.0f / Y_SCALE); }
        }
#pragma unroll
        for (int q = 0; q < 4; ++q) { float ss = 0.f;
#pragma unroll
            for (int j = 0; j < 4; ++j) ss += (z[q][j].x * z[q][j].x + z[q][j].y * z[q][j].y) + (z[q][j].z * z[q][j].z + z[q][j].w * z[q][j].w);
            sq[q] = ss; }
#pragma unroll
        for (int o = 1; o < 64; o <<= 1) {
#pragma unroll
            for (int q = 0; q < 4; ++q) sq[q] += __shfl_xor(sq[q], o); }
#pragma unroll
        for (int q = 0; q < 4; ++q) { const float rstd = 1.0f / sqrtf(sq[q] * (1.f / D) + RMS_EPS);
            GAS f32x4* xr = (GAS f32x4*)(F.out + (size_t)(t4 + q) * D) + F.lane;
#pragma unroll
            for (int j = 0; j < 4; ++j) __builtin_nontemporal_store(z[q][j] * rstd * gf[j], xr + 64 * j); }
    }
}

constexpr int N_PHASES = 10;
struct Args { const float* in[17]; float* out; unsigned char* ws; int ph_lo, ph_hi, li, pad; };
__global__ void __launch_bounds__(NWAVES * 64, 2) fwd_kernel(Args args) {
    extern __shared__ __attribute__((aligned(16))) unsigned char lds[];
    Frame F;
    F.lds = (LAS unsigned char*)lds;
    F.tid = threadIdx.x; F.lane = F.tid & 63; F.wave = __builtin_amdgcn_readfirstlane(F.tid >> 6);
    F.G = gridDim.x; { const int bx = blockIdx.x; F.vcu = (F.G % 8 == 0) ? (bx % 8) * (F.G / 8) + bx / 8 : bx; }
    unsigned char* ws = args.ws;
    F.ctl = (gu32*)(ws + WS_CTL);
    F.x = args.in[0]; F.g_mix = args.in[1]; F.w_in = args.in[2]; F.b_gate = args.in[3]; F.conv_w = args.in[4]; F.w_ao = args.in[5]; F.w_co = args.in[6]; F.w_out = args.in[7];
    F.g_ffn = args.in[8]; F.w_rg = args.in[9]; F.b_rg = args.in[10]; F.w_re = args.in[11]; F.b_re = args.in[12]; F.w1 = args.in[13]; F.w3 = args.in[14]; F.w2 = args.in[15]; F.g_fin = args.in[16];
    F.out = args.out;
    F.WinT = (bf16*)(ws + WS_WIN); F.WacT = (bf16*)(ws + WS_WAC); F.WoT = (bf16*)(ws + WS_WO); F.W13Q = ws + WS_W13; F.W2Q = ws + WS_W2; F.X1Q = ws + WS_X1Q; F.HIDQ = ws + WS_HID; F.XNQ = (unsigned char*)args.out + 64 * MiB; F.WinQ = ws + WS_WINQ;
    F.PROJ = (bf16*)(ws + WS_PROJ); F.XN = (bf16*)args.out; F.X1B = (bf16*)(ws + WS_X1B); F.Y = ws + WS_Y; F.irs1 = (float*)(ws + WS_IRS1);
    F.list = (int*)(ws + WS_LIST); F.wl = (float*)(ws + WS_WL); F.rsl = (float*)(ws + WS_RSL); F.tokinfo = (int*)(ws + WS_TOKINFO); F.WrT = (float*)(ws + WS_WRT);
    for (int u = F.tid; u < (LDS_ZERO_END - L_MISC) / 4; u += NWAVES * 64) ((LAS unsigned*)(F.lds + L_MISC))[u] = 0u;
    __syncthreads();
    volatile LAS unsigned* MISC = (volatile LAS unsigned*)(F.lds + L_MISC);
    XcdBarrier bar; bar.bar = (unsigned*)(F.ctl + CW_BAR); bar.x = 0; bar.st = nullptr;
    if (MK_N_LAUNCHES == 1) bar = xcd_barrier_post((unsigned*)(F.ctl + CW_BAR), MISC + 8);
#define GRID_BAR() do { if (MK_N_LAUNCHES == 1) xcd_barrier(bar); } while (0)
    const int lo = args.ph_lo, hi = args.ph_hi;
#ifndef PHASE_MASK
#define PHASE_MASK 0x3ff
#endif
#define IN(k) (((PHASE_MASK >> (k)) & 1) && lo <= (k) && (k) < hi)
#define BOTH(k) (IN(k) && IN((k) + 1))

    if (IN(0)) { TWICE(0, p0_prologue(F);); if (BOTH(0)) GRID_BAR(); }
    if (IN(1)) {
        TWICE(1,
        {
            pg8::Gemm g{(const bf16*)F.XNQ, (const bf16*)F.WinT, D / 2, D / 2, D / 2}; pg8::StaticOrder S; S.init(T, NPROJ, F.G, (int)blockIdx.x);
            pg8::EpiProjI8 E{F.PROJ, F.b_gate, F.irs1};
            pg8::gemm_phase<pg8::EpiProjI8, pg8::StaticOrder, true, false, 2>(F.lds, g, S, E);
        }
        );
        if (BOTH(1)) GRID_BAR();
    }
    if (IN(2)) {
#if defined(ATTN_NAIVE)
        p2_conv(F); p2_attn_naive(F);
#else
        p2_conv(F); if ((REPEAT_MASK >> 10) & 1) p2_conv(F, (bf16*)F.out);
#if defined(ATTN_V1)
        p2_attn_mfma(F);
#else
        p2_attn_v2(F);
#endif
#endif
        if (BOTH(2)) GRID_BAR(); }
    if (IN(3)) {
#if !defined(ATTN_NAIVE)
        TWICE(3, p3_merge(F););
#endif
        if (BOTH(3)) GRID_BAR(); }
    if (IN(4)) {
        TWICE(4,
        pg8::Gemm g{F.PROJ + PC_O, F.WacT, D, PROJ_LD, D}; pg8::StaticOrder S; S.init(T, D, F.G, (int)blockIdx.x);
        pg8::EpiMerged E{F.PROJ};
        pg8::gemm_phase<pg8::EpiMerged, pg8::StaticOrder, true, false>(F.lds, g, S, E);
        );
        if (BOTH(4)) GRID_BAR();
    }
    if (IN(5)) {
        TWICE(5,
        pg8::Gemm g{F.PROJ + PC_M, F.WoT, D, PROJ_LD, D}; pg8::StaticOrder S; S.init(T, D, F.G, (int)blockIdx.x);
        pg8::EpiOut E{F.x, F.X1B, F.X1Q};
        pg8::gemm_phase<pg8::EpiOut, pg8::StaticOrder, EPI_ALIGN_OUT, false>(F.lds, g, S, E);
        );
        if (BOTH(5)) GRID_BAR();
    }
    if (IN(6)) { p5_route(F); if (BOTH(6)) GRID_BAR(); }
    if (IN(7)) {
        TWICE(7,
        const int n = moe_tables(F, true);
        pg8::Gemm g{(const bf16*)F.X1Q, (const bf16*)F.W13Q, D / 2, D / 2, D / 2}; pg8::MoeOrder S{(const LAS int*)(F.lds + L_UTAB), (const LAS int*)(F.lds + L_GTAB), n};
        pg8::EpiHid E{F.HIDQ, F.rsl};
        pg8::gemm_phase<pg8::EpiHid, pg8::MoeOrder, true, true, true>(F.lds, g, S, E);
        );
        p7_w2_copy(F, 0);
        if (BOTH(7)) GRID_BAR();
    }
    if (IN(8)) {
        TWICE(8,
        const int n = moe_tables(F, false);
        pg8::Gemm g{(const bf16*)F.HIDQ, (const bf16*)F.W2Q, FF / 2, FF / 2, FF / 2}; pg8::MoeOrder S{(const LAS int*)(F.lds + L_UTAB), (const LAS int*)(F.lds + L_GTAB), n};
        pg8::EpiY E{F.Y, F.wl};
        pg8::gemm_phase<pg8::EpiY, pg8::MoeOrder, true, false, true>(F.lds, g, S, E);
        );
        if (BOTH(8)) GRID_BAR();
    }
    if (IN(9)) { TWICE(9, p8_final(F);); }
#undef IN
#undef BOTH
#undef GRID_BAR
}

extern "C" void kernel_launch(void* const* d_in, const int* in_sizes, int n_in, void* d_out, int out_size, void* d_ws, size_t ws_size, hipStream_t stream) {
    static int grid = 0;
    if (grid == 0) {
        if (n_in != 17 || in_sizes[0] != T * D || out_size != T * D || ws_size < WS_END) { fprintf(stderr, "kernel_launch: unexpected shapes (n_in %d, in0 %d, out %d, ws %zu)\n", n_in, n_in > 0 ? in_sizes[0] : -1, out_size, ws_size); grid = -1; return; }
        int dev = 0, cus = 0, per_cu = 0;
        if (hipGetDevice(&dev) != hipSuccess || hipDeviceGetAttribute(&cus, hipDeviceAttributeMultiprocessorCount, dev) != hipSuccess) { grid = -1; return; }
        if (hipFuncSetAttribute((const void*)fwd_kernel, hipFuncAttributeMaxDynamicSharedMemorySize, LDS_BYTES) != hipSuccess) { fprintf(stderr, "kernel_launch: hipFuncSetAttribute failed\n"); grid = -1; return; }
        if (hipOccupancyMaxActiveBlocksPerMultiprocessor(&per_cu, (const void*)fwd_kernel, NWAVES * 64, LDS_BYTES) != hipSuccess || per_cu < 1)
            fprintf(stderr, "kernel_launch: note: occupancy query reports %d workgroups per CU\n", per_cu);
        (void)hipGetLastError();
        grid = cus;
        if (grid != 256) fprintf(stderr, "kernel_launch: warning: %d CUs (built for 256)\n", grid);
    }
    if (grid < 0) return;
    (void)hipMemsetAsync((char*)d_ws + WS_CTL, 0, CTL_ZERO_BYTES, stream);
    Args a{};
    for (int i = 0; i < 17; ++i) a.in[i] = (const float*)d_in[i];
    a.out = (float*)d_out; a.ws = (unsigned char*)d_ws;
    if (MK_N_LAUNCHES == 1) {
#if defined(PROBE_PREFIX)
        a.ph_lo = 0; a.ph_hi = PROBE_PREFIX; a.li = 0;
        hipLaunchKernelGGL(fwd_kernel, dim3(grid), dim3(NWAVES * 64), LDS_BYTES, stream, a);
        (void)hipMemsetAsync((char*)d_ws + WS_CTL, 0, CTL_ZERO_BYTES, stream);
#endif
        a.ph_lo = 0; a.ph_hi = N_PHASES; a.li = 0;
        hipLaunchKernelGGL(fwd_kernel, dim3(grid), dim3(NWAVES * 64), LDS_BYTES, stream, a);
    } else {
        for (int p = 0; p < N_PHASES; ++p) { a.ph_lo = p; a.ph_hi = p + 1; a.li = p; hipLaunchKernelGGL(fwd_kernel, dim3(grid), dim3(NWAVES * 64), LDS_BYTES, stream, a); }
    }
}
```

```cpp
#include <hip/hip_runtime.h>
#include <cstdio>
#include <cstdint>

#ifndef REPEAT_MASK
#define REPEAT_MASK 0
#endif
#define TWICE(k, ...) do { { __VA_ARGS__ } if ((REPEAT_MASK >> (k)) & 1) { __VA_ARGS__ } } while (0)
#ifndef FP8_SCALE_ARG
#define FP8_SCALE_ARG 0x7F7F7F7F
#endif
#ifndef EPI_ALIGN_OUT
#define EPI_ALIGN_OUT true
#endif
#ifndef MK_N_LAUNCHES
#define MK_N_LAUNCHES 1
#endif

constexpr int BATCH = 4, SEQ = 8192, D = 1024, T = BATCH * SEQ;
constexpr int NPROJ = 6656;
constexpr int PROJ_LD = 5888;
constexpr int PC_Q0 = 0, PC_BG = 256, PC_Q1 = 1024, PC_Q2 = 1280, PC_K = 1536, PC_V = 2304, PC_U = 3072, PC_G = 3840;
constexpr int PC_O = 0, PC_C = 256, PC_M = 1024;
constexpr int NEXP = 32, FF = 512, CAP = T;
constexpr int MAXSLOT = 73728;
constexpr float RMS_EPS = 1e-6f;
constexpr float LOG2E = 1.4426950408889634f;
constexpr float W13_SCALE = 64.0f, W2_SCALE = 32.0f, WQ_SCALE = 256.0f, WKV_SCALE = 32.0f, Y_SCALE = 16.0f;
constexpr float QSCALE = 0.125f * LOG2E;
constexpr float MERGED_CLIP = 3.0f;
constexpr float W8_CLIP = 4.0f * 0.03125f;

constexpr size_t MiB = 1u << 20;
constexpr size_t WS_CTL = 0, CTL_ZERO_BYTES = 128 * 1024;
constexpr size_t WS_RL = 1 * MiB;
constexpr size_t WS_TOKINFO = 1 * MiB;
constexpr size_t WS_IRS1 = 1 * MiB + 768 * 1024;
constexpr size_t WS_WRT = 1 * MiB + 512 * 1024;
constexpr size_t WS_WAC = 2 * MiB;
constexpr size_t WS_WO = 4 * MiB;
constexpr size_t WS_LIST = 6 * MiB;
constexpr size_t WS_WL = 10 * MiB;
constexpr size_t WS_RSL = 14 * MiB;
constexpr size_t WS_WIN = 18 * MiB;
constexpr size_t WS_X1B = 32 * MiB;
constexpr size_t WS_PROJ = 96 * MiB;
constexpr size_t WS_W13 = WS_PROJ;
constexpr size_t WS_W2 = WS_PROJ + 64 * MiB;
constexpr size_t WS_HID = WS_PROJ + 96 * MiB;
constexpr size_t WS_Y = WS_PROJ + 168 * MiB;
constexpr size_t WS_X1Q = 464 * MiB;
constexpr size_t WS_WINQ = 496 * MiB;
constexpr size_t WS_END = 501 * MiB;
static_assert(WS_PROJ + (size_t)T * PROJ_LD * 2 <= WS_END && WS_Y + (size_t)MAXSLOT * 1024 * 2 <= WS_END, "d_ws map");
constexpr int CW_TMO = 0;
constexpr int CW_BAR = 4096;
constexpr int CW_CNT = 16384;

constexpr int RING_BYTES = 131072;
constexpr int L_MISC = RING_BYTES;
constexpr int L_HIST = L_MISC + 512;
constexpr int L_LBASE = L_HIST + 128;
constexpr int L_CNT = L_LBASE + 128;
constexpr int L_TPRE = L_CNT + 128;
constexpr int L_NU = L_TPRE + 256;
constexpr int L_UTAB = L_NU + 128;
constexpr int L_GTAB = L_UTAB + 256;
constexpr int L_REC = L_GTAB + 6 * 1024;
constexpr int LDS_ZERO_END = L_LBASE;
constexpr int LDS_BYTES = 147456;
static_assert(L_REC + 128 * 32 <= LDS_BYTES, "LDS map");
constexpr int MAXU = 6;

#define GAS __attribute__((address_space(1)))
#define LAS __attribute__((address_space(3)))
typedef unsigned short bf16;
typedef unsigned v4u __attribute__((ext_vector_type(4)));
typedef unsigned v2u __attribute__((ext_vector_type(2)));
typedef int v4i __attribute__((ext_vector_type(4)));
typedef float f32x4 __attribute__((ext_vector_type(4)));
typedef GAS unsigned gu32;
#define RLX_AGENT __ATOMIC_RELAXED, __HIP_MEMORY_SCOPE_AGENT
#define LDS_WAIT() asm volatile("s_waitcnt lgkmcnt(0)" ::: "memory")
#define VM_WAIT() asm volatile("s_waitcnt vmcnt(0)" ::: "memory")
__device__ __forceinline__ unsigned f2bf(float f) { unsigned u = __builtin_bit_cast(unsigned, f); return (u + 0x7fffu + ((u >> 16) & 1u)) >> 16; }
__device__ __forceinline__ unsigned pk2(float lo, float hi) { return f2bf(lo) | (f2bf(hi) << 16); }
__device__ __forceinline__ float bflo(unsigned w) { return __builtin_bit_cast(float, w << 16); }
__device__ __forceinline__ float bfhi(unsigned w) { return __builtin_bit_cast(float, w & 0xffff0000u); }
__device__ __forceinline__ float fast_exp2(float x) { return __builtin_amdgcn_exp2f(x); }
__device__ __forceinline__ float fast_rcp(float x) { return __builtin_amdgcn_rcpf(x); }
__device__ __forceinline__ float sigmoidf_(float z) { return fast_rcp(1.0f + fast_exp2(-z * LOG2E)); }

__device__ __forceinline__ unsigned pack4_i8(float a, float b, float c, float d) {
    const int q0 = (int)__builtin_rintf(fminf(fmaxf(a, -127.f), 127.f)), q1 = (int)__builtin_rintf(fminf(fmaxf(b, -127.f), 127.f)), q2 = (int)__builtin_rintf(fminf(fmaxf(c, -127.f), 127.f)), q3 = (int)__builtin_rintf(fminf(fmaxf(d, -127.f), 127.f));
    return (unsigned)(q0 & 255) | ((unsigned)(q1 & 255) << 8) | ((unsigned)(q2 & 255) << 16) | ((unsigned)q3 << 24);
}

namespace pg8 {
#define PG8_LAS __attribute__((address_space(3)))
typedef unsigned short bf16_t;
typedef short bf16x8 __attribute__((ext_vector_type(8)));
typedef float f32x4 __attribute__((ext_vector_type(4)));
typedef unsigned u32x4 __attribute__((ext_vector_type(4)));
typedef unsigned u32x2 __attribute__((ext_vector_type(2)));
constexpr int BM = 256, BK = 64, HALF = 128, HTB = HALF * BK * 2, STAGE_BYTES = 8 * HTB, NXCD = 8, WGM = 8;

__host__ __device__ __forceinline__ int lds_byte(int r, int c) { const int st = (r >> 4) * 2 + (c >> 5), rr = r & 15, cc = c & 31, ob = rr * 64 + cc * 2; return st * 1024 + (ob ^ (((ob >> 9) & 1) << 5)); }
__host__ __device__ __forceinline__ void stage_rc(int b, int& R, int& C) { const int st = b / 1024, sb = b % 1024, swz = sb ^ (((sb >> 9) & 1) << 5); R = (st >> 1) * 16 + swz / 64; C = (st & 1) * 32 + (swz % 64) / 2; }
__host__ __device__ __forceinline__ int perm32(int rho) { const int n = rho >> 4, i = rho & 15; return 8 * (i >> 2) + 4 * n + (i & 3); }

struct Unit { int pm, pn, e, pos0, rows; };
struct Gemm { const bf16_t* A; const bf16_t* Bt; int K, lda, ldb; };

struct StaticOrder {
    int nM, nN, nwg, G, c;
    __device__ void init(int M, int N, int G_, int c_) { nM = M / BM; nN = N / BM; nwg = nM * nN; G = G_; c = c_; }
    __device__ bool next(int i, Unit& u) const {
        const long L = (long)i * G + c; if (L >= nwg) return false;
        int wgid = (int)L; { const int q = nwg / NXCD, r = nwg % NXCD, xcd = wgid % NXCD, off = wgid / NXCD; wgid = (xcd < r ? xcd * (q + 1) : r * (q + 1) + (xcd - r) * q) + off; }
        const int nig = WGM * nN, gid = wgid / nig, fm = gid * WGM, gsz = (nM - fm) < WGM ? (nM - fm) : WGM;
        u.pm = fm + ((wgid % nig) % gsz); u.pn = (wgid % nig) / gsz; u.e = 0; u.pos0 = 0; u.rows = BM; return true;
    }
    __device__ __forceinline__ int gather_tok(int, int) const { return 0; }
};
template <bool QKV> struct MapOrder : StaticOrder {
    __device__ bool next(int i, Unit& u) const {
        if (!StaticOrder::next(i, u)) return false;
        if (QKV) { u.e = u.pn == 0 ? 0 : (u.pn < 9 ? u.pn + 3 : u.pn + 9); }
        else { u.pn = u.pn < 3 ? u.pn + 1 : u.pn + 9; u.e = u.pn; }
        return true;
    }
};
struct MoeOrder {
    const PG8_LAS int* utab; const PG8_LAS int* gtab; int n;
    __device__ __forceinline__ bool next(int i, Unit& u) const {
        if (i >= n) return false;
        u.pm = __builtin_amdgcn_readfirstlane(utab[i * 8 + 0]); u.pn = __builtin_amdgcn_readfirstlane(utab[i * 8 + 1]); u.e = __builtin_amdgcn_readfirstlane(utab[i * 8 + 2]);
        u.pos0 = __builtin_amdgcn_readfirstlane(utab[i * 8 + 3]); u.rows = __builtin_amdgcn_readfirstlane(utab[i * 8 + 4]); return true;
    }
    __device__ __forceinline__ int gather_tok(int ui, int r) const { return gtab[ui * 256 + r]; }
};

typedef float f32x2_t __attribute__((ext_vector_type(2))); typedef __bf16 bf16x2_t __attribute__((ext_vector_type(2)));
__device__ __forceinline__ unsigned cvt_pk_bf16(float lo, float hi) { const f32x2_t v = {lo, hi}; const bf16x2_t b = __builtin_convertvector(v, bf16x2_t); return __builtin_bit_cast(unsigned, b); }
__device__ __forceinline__ u32x4 pack8(const f32x4 v0, const f32x4 v1) { u32x4 w; w.x = cvt_pk_bf16(v0[0], v0[1]); w.y = cvt_pk_bf16(v0[2], v0[3]); w.z = cvt_pk_bf16(v1[0], v1[1]); w.w = cvt_pk_bf16(v1[2], v1[3]); return w; }

typedef int i32x8 __attribute__((ext_vector_type(8))); typedef int i32x4 __attribute__((ext_vector_type(4)));
__device__ __forceinline__ i32x8 cat8(const bf16x8 a, const bf16x8 b) { const i32x4 x = __builtin_bit_cast(i32x4, a), y = __builtin_bit_cast(i32x4, b); return __builtin_shufflevector(x, y, 0, 1, 2, 3, 4, 5, 6, 7); }
__device__ __forceinline__ void mfma_fp8_inplace(f32x4& acc, const i32x8 a, const i32x8 b) {
    asm volatile("v_mfma_f32_16x16x128_f8f6f4 %0, %1, %2, %0" : "+v"(acc) : "v"(a), "v"(b));
}
__device__ __forceinline__ u32x2 pack8_fp8(const f32x4 v0, const f32x4 v1) { u32x2 w; int t = 0; t = __builtin_amdgcn_cvt_pk_fp8_f32(v0[0], v0[1], t, false); t = __builtin_amdgcn_cvt_pk_fp8_f32(v0[2], v0[3], t, true); w.x = (unsigned)t;
    t = 0; t = __builtin_amdgcn_cvt_pk_fp8_f32(v1[0], v1[1], t, false); t = __builtin_amdgcn_cvt_pk_fp8_f32(v1[2], v1[3], t, true); w.y = (unsigned)t; return w; }
template <class Epi, class Sched, bool ALIGN_EPI, bool GATHER, int QM = 0>
__device__ __forceinline__ void gemm_phase(PG8_LAS unsigned char* lds, const Gemm g, const Sched& S, const Epi& E) {
    const int tid = threadIdx.x, wid = __builtin_amdgcn_readfirstlane(tid >> 6), lane = tid & 63, wr = wid >> 2, wc = wid & 3, fr = lane & 15, fq = lane >> 4;
    const int K = g.K, nt = K / BK;
    const unsigned ldaB = (unsigned)g.lda * 2u, ldbB = (unsigned)g.ldb * 2u;
    int RA[2]; unsigned cA2[2], vB0[2], vB1[2];
#pragma unroll
    for (int i = 0; i < 2; ++i) { int R, C; stage_rc(tid * 16 + i * 8192, R, C); const int Rb = Epi::PERM ? ((R & ~31) + perm32(R & 31)) : R;
        RA[i] = R; cA2[i] = (unsigned)C * 2u; vB0[i] = (unsigned)Rb * ldbB + (unsigned)C * 2u; vB1[i] = vB0[i] + (unsigned)HALF * ldbB; }
    const size_t kstep = (size_t)(BK * 2);
    const size_t tstepA = (size_t)BM * ldaB, tstepB = (size_t)BM * ldbB;
    const unsigned ldsw = (unsigned)wid * 1024u;
    constexpr bool FP8 = (QM == 1);
    const int aoff = lds_byte(wr * 64 + fr, fq * 8), boff = lds_byte(wc * 32 + fr, fq * 8);
    constexpr int KSTR = 1024;
#define PG8_SA(b, h) (((b) * 2 + (h)) * HTB)
#define PG8_SB(b, h) ((4 + (b) * 2 + (h)) * HTB)
#define PG8_STAGE(bufoff, gbase, voff) do { _Pragma("unroll") for (int _i = 0; _i < 2; ++_i) \
        __builtin_amdgcn_global_load_lds((const unsigned*)((const char*)(gbase) + (voff)[_i]), (PG8_LAS unsigned*)(lds + (bufoff) + ldsw + _i * 8192), 16, 0, 0); } while (0)
#define PG8_LDA(dst, b, h) do { _Pragma("unroll") for (int m = 0; m < 4; ++m) _Pragma("unroll") for (int k = 0; k < 2; ++k) dst[m][k] = *(const PG8_LAS bf16x8*)(lds + PG8_SA(b, h) + aoff + m * 2048 + k * KSTR); } while (0)
#define PG8_LDB(dst, b, h) do { _Pragma("unroll") for (int n = 0; n < 2; ++n) _Pragma("unroll") for (int k = 0; k < 2; ++k) dst[n][k] = *(const PG8_LAS bf16x8*)(lds + PG8_SB(b, h) + boff + n * 2048 + k * KSTR); } while (0)
#define PG8_MMA(ai, bj, At, Bt) do { __builtin_amdgcn_s_setprio(1); _Pragma("unroll") for (int m = 0; m < 4; ++m) _Pragma("unroll") for (int n = 0; n < 2; ++n) { \
        if constexpr (FP8) { mfma_fp8_inplace(acc[ai][bj][m][n], cat8(Bt[n][0], Bt[n][1]), cat8(At[m][0], At[m][1])); } \
        else if constexpr (QM == 2) { _Pragma("unroll") for (int k = 0; k < 2; ++k) acc[ai][bj][m][n] = __builtin_bit_cast(f32x4, __builtin_amdgcn_mfma_i32_16x16x64_i8(__builtin_bit_cast(i32x4, Bt[n][k]), __builtin_bit_cast(i32x4, At[m][k]), __builtin_bit_cast(i32x4, acc[ai][bj][m][n]), 0, 0, 0)); } \
        else { _Pragma("unroll") for (int k = 0; k < 2; ++k) acc[ai][bj][m][n] = __builtin_amdgcn_mfma_f32_16x16x32_bf16(Bt[n][k], At[m][k], acc[ai][bj][m][n], 0, 0, 0); } } \
        __builtin_amdgcn_s_setprio(0); } while (0)
#define PG8_WAIT_V(n) asm volatile("s_waitcnt vmcnt(" #n ")" ::: "memory")
#define PG8_WAIT_L(n) asm volatile("s_waitcnt lgkmcnt(" #n ")" ::: "memory")
#define PG8_BAR __builtin_amdgcn_s_barrier()
#define PG8_SCHED __builtin_amdgcn_sched_barrier(0)
#define PG8_SETA(v, ui) do { _Pragma("unroll") for (int _i = 0; _i < 2; ++_i) { \
        if constexpr (GATHER) { (v)[0][_i] = (unsigned)S.gather_tok((ui), RA[_i]) * ldaB + cA2[_i]; (v)[1][_i] = (unsigned)S.gather_tok((ui), RA[_i] + HALF) * ldaB + cA2[_i]; } \
        else { (v)[0][_i] = (unsigned)RA[_i] * ldaB + cA2[_i]; (v)[1][_i] = (v)[0][_i] + (unsigned)HALF * ldaB; } } } while (0)
    Unit cur, nxt; int ui = 0;
    if (!S.next(0, cur)) return;
    f32x4 acc[2][2][4][2];
#pragma unroll
    for (int a = 0; a < 2; ++a)
#pragma unroll
        for (int b = 0; b < 2; ++b)
#pragma unroll
            for (int m = 0; m < 4; ++m)
#pragma unroll
                for (int n = 0; n < 2; ++n) acc[a][b][m][n] = (f32x4){0.f, 0.f, 0.f, 0.f};
    bf16x8 At[4][2], B0[2][2], B1[2][2];
    unsigned vA[2][2], nvA[2][2];
    PG8_SETA(vA, 0);
#pragma unroll
    for (int i = 0; i < 2; ++i) { nvA[0][i] = vA[0][i]; nvA[1][i] = vA[1][i]; }
    const char* cA = GATHER ? (const char*)g.A : (const char*)g.A + (size_t)cur.pm * tstepA; const char* cB = (const char*)g.Bt + (size_t)cur.pn * tstepB;
    PG8_STAGE(PG8_SB(0, 0), cB, vB0); PG8_STAGE(PG8_SB(0, 1), cB, vB1); PG8_STAGE(PG8_SA(0, 0), cA, vA[0]); PG8_STAGE(PG8_SA(0, 1), cA, vA[1]);
    if (wr == 1) PG8_BAR;
    PG8_WAIT_V(2); PG8_BAR;
    PG8_STAGE(PG8_SB(1, 0), cB + kstep, vB0); PG8_STAGE(PG8_SA(1, 0), cA + kstep, vA[0]); PG8_STAGE(PG8_SB(1, 1), cB + kstep, vB1);
    PG8_WAIT_V(6); PG8_BAR;
    for (;;) {
        const bool has_next = S.next(ui + 1, nxt);
        const char* nA = GATHER ? cA : (has_next ? (const char*)g.A + (size_t)nxt.pm * tstepA : cA);
        const char* nB = has_next ? (const char*)g.Bt + (size_t)nxt.pn * tstepB : cB;
        if constexpr (GATHER) { if (has_next) { PG8_SETA(nvA, ui + 1); } }
#pragma unroll 1
        for (int t = 0; t < nt; t += 2) {
            if constexpr (FP8) asm volatile("" : "+v"(vA[0][0]), "+v"(vA[0][1]), "+v"(vA[1][0]), "+v"(vA[1][1]), "+v"(vB0[0]), "+v"(vB0[1]), "+v"(vB1[0]), "+v"(vB1[1]));
            const bool last = (t == nt - 2);
            const char* a1 = cA + (size_t)(t + 1) * kstep;
            const char* a2 = last ? nA : cA + (size_t)(t + 2) * kstep; const char* b2 = last ? nB : cB + (size_t)(t + 2) * kstep;
            const char* a3 = a2 + kstep; const char* b3 = b2 + kstep;
            unsigned w0[2], w1[2];
#pragma unroll
            for (int i = 0; i < 2; ++i) { if constexpr (GATHER) { w0[i] = last ? nvA[0][i] : vA[0][i]; w1[i] = last ? nvA[1][i] : vA[1][i]; } else { w0[i] = vA[0][i]; w1[i] = vA[1][i]; } }
            PG8_LDB(B0, 0, 0); PG8_LDB(B1, 0, 1); PG8_SCHED; PG8_LDA(At, 0, 0); PG8_STAGE(PG8_SA(1, 1), a1, vA[1]);
            PG8_WAIT_V(8); PG8_WAIT_L(0); PG8_BAR; PG8_MMA(0, 0, At, B0); PG8_MMA(0, 1, At, B1); PG8_BAR; PG8_SCHED;
            PG8_LDA(At, 0, 1); PG8_STAGE(PG8_SB(0, 0), b2, vB0); PG8_STAGE(PG8_SB(0, 1), b2, vB1); PG8_STAGE(PG8_SA(0, 0), a2, w0);
            PG8_WAIT_V(8); PG8_WAIT_L(0); PG8_BAR; PG8_MMA(1, 0, At, B0); PG8_MMA(1, 1, At, B1); PG8_BAR; PG8_SCHED;
            PG8_LDB(B0, 1, 0); PG8_LDB(B1, 1, 1); PG8_SCHED; PG8_LDA(At, 1, 0); PG8_STAGE(PG8_SA(0, 1), a2, w1);
            PG8_WAIT_V(8); PG8_WAIT_L(0); PG8_BAR; PG8_MMA(0, 0, At, B0); PG8_MMA(0, 1, At, B1); PG8_BAR; PG8_SCHED;
            PG8_LDA(At, 1, 1); PG8_STAGE(PG8_SB(1, 0), b3, vB0); PG8_STAGE(PG8_SB(1, 1), b3, vB1); PG8_STAGE(PG8_SA(1, 0), a3, w0);
            PG8_WAIT_V(8); PG8_WAIT_L(0); PG8_BAR; PG8_MMA(1, 0, At, B0); PG8_MMA(1, 1, At, B1); PG8_BAR; PG8_SCHED;
            if constexpr (Epi::HAS_MID) { if (t == Epi::MID_T) E.mid(acc, cur, wr, wc, fr, fq); }
        }
        if constexpr (FP8) asm volatile("s_nop 15\n\ts_nop 15" ::: "memory");
        if constexpr (ALIGN_EPI) { if (wr == 0) PG8_BAR; }
        E(acc, cur, wr, wc, fr, fq);
        if (!has_next) break;
#pragma unroll
        for (int a = 0; a < 2; ++a)
#pragma unroll
            for (int b = 0; b < 2; ++b)
#pragma unroll
                for (int m = 0; m < 4; ++m)
#pragma unroll
                    for (int n = 0; n < 2; ++n) acc[a][b][m][n] = (f32x4){0.f, 0.f, 0.f, 0.f};
        cur = nxt; cA = nA; cB = nB; ++ui;
        if constexpr (GATHER) {
#pragma unroll
            for (int i = 0; i < 2; ++i) { vA[0][i] = nvA[0][i]; vA[1][i] = nvA[1][i]; }
        }
        if constexpr (ALIGN_EPI) { if (wr == 1) PG8_BAR; }
    }
    PG8_WAIT_V(0);
    if constexpr (!ALIGN_EPI) { if (wr == 0) PG8_BAR; }
    PG8_BAR;
#undef PG8_SA
#undef PG8_SB
#undef PG8_STAGE
#undef PG8_LDA
#undef PG8_LDB
#undef PG8_MMA
#undef PG8_WAIT_V
#undef PG8_WAIT_L
#undef PG8_BAR
#undef PG8_SCHED
#undef PG8_SETA
}

struct EpiProj {
    static constexpr bool PERM = true, HAS_MID = false; static constexpr int MID_T = -1;
    bf16_t* P; const float* bgate;
    __device__ __forceinline__ void mid(f32x4 (&)[2][2][4][2], const Unit&, int, int, int, int) const {}
    __device__ __forceinline__ void operator()(const f32x4 (&acc)[2][2][4][2], const Unit& u, int wr, int wc, int fr, int fq) const {
        asm volatile("" : "+v"(fr), "+v"(fq));
        const int row0 = u.pm * BM + wr * 64 + fr; const int pn = u.e;
        if (pn < 12) {
            const int col0 = pn * 256 + wc * 32 + 8 * fq;
#pragma unroll
            for (int ai = 0; ai < 2; ++ai)
#pragma unroll
                for (int m = 0; m < 4; ++m) { bf16_t* rowp = P + (size_t)(row0 + ai * HALF + m * 16) * PROJ_LD + col0;
#pragma unroll
                    for (int bj = 0; bj < 2; ++bj) *(u32x4*)(rowp + bj * HALF) = pack8(acc[ai][bj][m][0], acc[ai][bj][m][1]); }
        } else if (pn < 18) {
            const int col0 = PC_U + (pn - 12) * 128 + wc * 32 + 8 * fq;
#pragma unroll
            for (int ai = 0; ai < 2; ++ai)
#pragma unroll
                for (int m = 0; m < 4; ++m) { bf16_t* rowp = P + (size_t)(row0 + ai * HALF + m * 16) * PROJ_LD + col0;
                    *(u32x4*)rowp = pack8(acc[ai][0][m][0] * acc[ai][1][m][0], acc[ai][0][m][1] * acc[ai][1][m][1]); }
        } else {
            const int cg0 = (pn - 18) * 256 + wc * 32 + 8 * fq;
            f32x4 bv[2][2];
#pragma unroll
            for (int bj = 0; bj < 2; ++bj)
#pragma unroll
                for (int n = 0; n < 2; ++n) bv[bj][n] = *(const f32x4*)(bgate + cg0 + bj * HALF + 4 * n);
#pragma unroll
            for (int ai = 0; ai < 2; ++ai)
#pragma unroll
                for (int m = 0; m < 4; ++m) { bf16_t* rowp = P + (size_t)(row0 + ai * HALF + m * 16) * PROJ_LD + PC_G + cg0;
#pragma unroll
                    for (int bj = 0; bj < 2; ++bj) { f32x4 z0 = acc[ai][bj][m][0] + bv[bj][0], z1 = acc[ai][bj][m][1] + bv[bj][1];
#if !defined(DBG_NO_SIG)
#pragma unroll
                        for (int j = 0; j < 4; ++j) { z0[j] = sigmoidf_(z0[j]); z1[j] = sigmoidf_(z1[j]); }
#endif
                        *(u32x4*)(rowp + bj * HALF) = pack8(z0, z1); } }
        }
    }
};
struct EpiProjI8 {
    static constexpr bool PERM = true, HAS_MID = false; static constexpr int MID_T = -1;
    bf16_t* P; const float* bgate; const float* sx;
    __device__ __forceinline__ void mid(f32x4 (&)[2][2][4][2], const Unit&, int, int, int, int) const {}
    __device__ __forceinline__ f32x4 deq(const f32x4 a, float s) const { const i32x4 ai = __builtin_bit_cast(i32x4, a); return __builtin_convertvector(ai, f32x4) * s; }
    __device__ __forceinline__ void operator()(const f32x4 (&acc)[2][2][4][2], const Unit& u, int wr, int wc, int fr, int fq) const {
        asm volatile("" : "+v"(fr), "+v"(fq));
        const int row0 = u.pm * BM + wr * 64 + fr; const int pn = u.pn;
        const float sw = (pn == 0 || pn == 4 || pn == 5) ? (W8_CLIP * QSCALE / 127.0f) : (W8_CLIP / 127.0f);
        if (pn >= 6 && pn < 12) {
            const int col0 = (pn - 6) * 256 + wc * 32 + 8 * fq;
#pragma unroll
            for (int ai = 0; ai < 2; ++ai)
#pragma unroll
                for (int m = 0; m < 4; ++m) { const int row = row0 + ai * HALF + m * 16; const float s_ = sx[row] * sw; unsigned char* rowp = (unsigned char*)(P + (size_t)row * PROJ_LD + PC_K) + col0;
#pragma unroll
                    for (int bj = 0; bj < 2; ++bj) *(u32x2*)(rowp + bj * HALF) = pack8_fp8(deq(acc[ai][bj][m][0], s_), deq(acc[ai][bj][m][1], s_)); }
        } else if (pn < 12) {
            const int col0 = pn * 256 + wc * 32 + 8 * fq;
#pragma unroll
            for (int ai = 0; ai < 2; ++ai)
#pragma unroll
                for (int m = 0; m < 4; ++m) { const int row = row0 + ai * HALF + m * 16; const float s_ = sx[row] * sw; bf16_t* rowp = P + (size_t)row * PROJ_LD + col0;
#pragma unroll
                    for (int bj = 0; bj < 2; ++bj) *(u32x4*)(rowp + bj * HALF) = pack8(deq(acc[ai][bj][m][0], s_), deq(acc[ai][bj][m][1], s_)); }
        } else if (pn < 18) {
            const int col0 = PC_U + (pn - 12) * 128 + wc * 32 + 8 * fq;
#pragma unroll
            for (int ai = 0; ai < 2; ++ai)
#pragma unroll
                for (int m = 0; m < 4; ++m) { const int row = row0 + ai * HALF + m * 16; const float s_ = sx[row] * sw; bf16_t* rowp = P + (size_t)row * PROJ_LD + col0;
                    *(u32x4*)rowp = pack8(deq(acc[ai][0][m][0], s_) * deq(acc[ai][1][m][0], s_), deq(acc[ai][0][m][1], s_) * deq(acc[ai][1][m][1], s_)); }
        } else {
            const int cg0 = (pn - 18) * 256 + wc * 32 + 8 * fq;
            f32x4 bv[2][2];
#pragma unroll
            for (int bj = 0; bj < 2; ++bj)
#pragma unroll
                for (int n = 0; n < 2; ++n) bv[bj][n] = *(const f32x4*)(bgate + cg0 + bj * HALF + 4 * n) * (-LOG2E);
#pragma unroll
            for (int ai = 0; ai < 2; ++ai)
#pragma unroll
                for (int m = 0; m < 4; ++m) { const int row = row0 + ai * HALF + m * 16; const float s_ = sx[row] * sw * (-LOG2E); unsigned char* rowp = (unsigned char*)(P + (size_t)row * PROJ_LD + PC_G) + cg0;
#pragma unroll
                    for (int bj = 0; bj < 2; ++bj) { const f32x4 z0 = deq(acc[ai][bj][m][0], s_) + bv[bj][0], z1 = deq(acc[ai][bj][m][1], s_) + bv[bj][1];
                        u32x2 w8; unsigned t0 = 0u, t1 = 0u;
#pragma unroll
                        for (int j = 0; j < 4; ++j) {
                            t0 = __builtin_amdgcn_cvt_pk_u8_f32(__builtin_rintf(fast_rcp(fast_exp2(z0[j]) * (1.0f / 255.0f) + (1.0f / 255.0f))), j, t0);
                            t1 = __builtin_amdgcn_cvt_pk_u8_f32(__builtin_rintf(fast_rcp(fast_exp2(z1[j]) * (1.0f / 255.0f) + (1.0f / 255.0f))), j, t1); }
                        w8.x = t0; w8.y = t1;
                        *(u32x2*)(rowp + bj * HALF) = w8; } }
        }
    }
};
struct EpiProjQ {
    static constexpr bool PERM = true, HAS_MID = false; static constexpr int MID_T = -1;
    bf16_t* P; const float* bgate;
    __device__ __forceinline__ void mid(f32x4 (&)[2][2][4][2], const Unit&, int, int, int, int) const {}
    __device__ __forceinline__ void operator()(const f32x4 (&acc)[2][2][4][2], const Unit& u, int wr, int wc, int fr, int fq) const {
        asm volatile("" : "+v"(fr), "+v"(fq));
        const int row0 = u.pm * BM + wr * 64 + fr; const int pn = u.e; const float sc = (pn == 0 || pn == 4 || pn == 5) ? (1.0f / WQ_SCALE) : (1.0f / WKV_SCALE);
        if (pn >= 18) {
            const int cg0 = (pn - 18) * 256 + wc * 32 + 8 * fq;
            f32x4 bv[2][2];
#pragma unroll
            for (int bj = 0; bj < 2; ++bj)
#pragma unroll
                for (int n = 0; n < 2; ++n) bv[bj][n] = *(const f32x4*)(bgate + cg0 + bj * HALF + 4 * n);
#pragma unroll
            for (int ai = 0; ai < 2; ++ai)
#pragma unroll
                for (int m = 0; m < 4; ++m) { bf16_t* rowp = P + (size_t)(row0 + ai * HALF + m * 16) * PROJ_LD + PC_G + cg0;
#pragma unroll
                    for (int bj = 0; bj < 2; ++bj) { f32x4 z0 = acc[ai][bj][m][0] * sc + bv[bj][0], z1 = acc[ai][bj][m][1] * sc + bv[bj][1];
#pragma unroll
                        for (int j = 0; j < 4; ++j) { z0[j] = sigmoidf_(z0[j]); z1[j] = sigmoidf_(z1[j]); }
                        *(u32x4*)(rowp + bj * HALF) = pack8(z0, z1); } }
            return;
        }
        const int col0 = pn * 256 + wc * 32 + 8 * fq;
#pragma unroll
        for (int ai = 0; ai < 2; ++ai)
#pragma unroll
            for (int m = 0; m < 4; ++m) { bf16_t* rowp = P + (size_t)(row0 + ai * HALF + m * 16) * PROJ_LD + col0;
#pragma unroll
                for (int bj = 0; bj < 2; ++bj) *(u32x4*)(rowp + bj * HALF) = pack8(acc[ai][bj][m][0] * sc, acc[ai][bj][m][1] * sc); }
    }
};
struct EpiMerged {
#if defined(DBG_NO_HOOK)
    static constexpr bool PERM = true, HAS_MID = false; static constexpr int MID_T = 2;
#else
    static constexpr bool PERM = true, HAS_MID = true; static constexpr int MID_T = 2;
#endif
    bf16_t* P; const float* sM;
    static __device__ __forceinline__ float ub(unsigned w, int i) { return (float)((w >> (8 * i)) & 0xffu); }
    __device__ __forceinline__ void mid(f32x4 (&acc)[2][2][4][2], const Unit& u, int wr, int wc, int fr, int fq) const {
        int row0 = u.pm * BM + wr * 64 + fr; int col0 = u.pn * 256 + wc * 32 + 8 * fq;
        asm volatile("" : "+v"(row0), "+v"(col0));
#pragma unroll
        for (int ai = 0; ai < 2; ++ai)
#pragma unroll
            for (int m = 0; m < 4; ++m) { const unsigned char* gp = (const unsigned char*)(P + (size_t)(row0 + ai * HALF + m * 16) * PROJ_LD + PC_G) + col0;
#pragma unroll
                for (int bj = 0; bj < 2; ++bj) { const u32x2 a = *(const u32x2*)(gp + bj * HALF), b = *(const u32x2*)(gp + 1024 + bj * HALF);
#pragma unroll
                    for (int n = 0; n < 2; ++n)
#pragma unroll
                        for (int i = 0; i < 4; ++i) acc[ai][bj][m][n][i] *= ub(a[n], i) * fast_rcp(fmaxf(ub(b[n], i), 1.0f)); }
                asm volatile("" ::: "memory"); }
    }
    __device__ __forceinline__ void operator()(const f32x4 (&acc)[2][2][4][2], const Unit& u, int wr, int wc, int fr, int fq) const {
        asm volatile("" : "+v"(fr), "+v"(fq));
        int row0 = u.pm * BM + wr * 64 + fr; int col0 = u.pn * 256 + wc * 32 + 8 * fq;
        asm volatile("" : "+v"(row0), "+v"(col0));
#pragma unroll
        for (int ai = 0; ai < 2; ++ai)
#pragma unroll
            for (int m = 0; m < 4; ++m) { bf16_t* rp = P + (size_t)(row0 + ai * HALF + m * 16) * PROJ_LD;
#pragma unroll
                for (int bj = 0; bj < 2; ++bj) { const u32x2 b = *(const u32x2*)((const unsigned char*)(rp + PC_G) + 1024 + col0 + bj * HALF);
                    f32x4 v0 = acc[ai][bj][m][0], v1 = acc[ai][bj][m][1];
#pragma unroll
                    for (int i = 0; i < 4; ++i) { v0[i] *= fmaxf(ub(b.x, i), 1.0f) * (1.0f / 255.0f); v1[i] *= fmaxf(ub(b.y, i), 1.0f) * (1.0f / 255.0f); }
                    const float iq = 1.0f / sM[row0 + ai * HALF + m * 16];
                    u32x2 w8; w8.x = pack4_i8(v0[0] * iq, v0[1] * iq, v0[2] * iq, v0[3] * iq); w8.y = pack4_i8(v1[0] * iq, v1[1] * iq, v1[2] * iq, v1[3] * iq);
                    *(u32x2*)((unsigned char*)rp + 2048 + col0 + bj * HALF) = w8; }
                asm volatile("" ::: "memory"); }
    }
};
struct EpiOut {
    static constexpr bool PERM = true, HAS_MID = false; static constexpr int MID_T = -1;
    const float* x; bf16_t* x1b; unsigned char* x1q; const float* sM;
    __device__ __forceinline__ void mid(f32x4 (&)[2][2][4][2], const Unit&, int, int, int, int) const {}
    __device__ __forceinline__ void operator()(const f32x4 (&acc)[2][2][4][2], const Unit& u, int wr, int wc, int fr, int fq) const {
        asm volatile("" : "+v"(fr), "+v"(fq));
        const int row0 = u.pm * BM + wr * 64 + fr; const int col0 = u.pn * 256 + wc * 32 + 8 * fq;
#pragma unroll
        for (int ai = 0; ai < 2; ++ai)
#pragma unroll
            for (int m = 0; m < 4; ++m) { const size_t off = (size_t)(row0 + ai * HALF + m * 16) * D + col0; const float sc = sM[row0 + ai * HALF + m * 16] * (W8_CLIP / 127.0f);
#pragma unroll
                for (int bj = 0; bj < 2; ++bj) { const f32x4 o0 = *(const f32x4*)(x + off + bj * HALF) + __builtin_convertvector(__builtin_bit_cast(i32x4, acc[ai][bj][m][0]), f32x4) * sc, o1 = *(const f32x4*)(x + off + bj * HALF + 4) + __builtin_convertvector(__builtin_bit_cast(i32x4, acc[ai][bj][m][1]), f32x4) * sc;
                    *(u32x4*)(x1b + off + bj * HALF) = pack8(o0, o1); *(u32x2*)(x1q + off + bj * HALF) = pack8_fp8(o0, o1); } }
    }
};
struct EpiHid {
    static constexpr bool PERM = true, HAS_MID = false; static constexpr int MID_T = -1;
    unsigned char* H; const float* rsl;
    __device__ __forceinline__ void mid(f32x4 (&)[2][2][4][2], const Unit&, int, int, int, int) const {}
    __device__ __forceinline__ void operator()(const f32x4 (&acc)[2][2][4][2], const Unit& u, int wr, int wc, int fr, int fq) const {
        asm volatile("" : "+v"(fr), "+v"(fq));
        const int rl0 = wr * 64 + fr; const int col0 = (u.pn & 3) * 128 + wc * 32 + 8 * fq;
#pragma unroll
        for (int ai = 0; ai < 2; ++ai)
#pragma unroll
            for (int m = 0; m < 4; ++m) { const int rl = rl0 + ai * HALF + m * 16; const float rs = rl < u.rows ? rsl[(size_t)u.e * CAP + u.pos0 + rl] * (1.0f / W13_SCALE) : 0.f;
                f32x4 h0, h1;
#pragma unroll
                for (int j = 0; j < 4; ++j) { const float a0 = acc[ai][0][m][0][j] * rs, b0 = acc[ai][1][m][0][j] * rs, a1 = acc[ai][0][m][1][j] * rs, b1 = acc[ai][1][m][1][j] * rs;
                    h0[j] = a0 * sigmoidf_(a0) * b0; h1[j] = a1 * sigmoidf_(a1) * b1; }
                *(u32x2*)(H + (size_t)(u.pm * BM + rl) * FF + col0) = pack8_fp8(h0, h1); }
    }
};
struct EpiY {
    static constexpr bool PERM = true, HAS_MID = false; static constexpr int MID_T = -1;
    unsigned char* Y; const float* wl;
    __device__ __forceinline__ void mid(f32x4 (&)[2][2][4][2], const Unit&, int, int, int, int) const {}
    __device__ __forceinline__ void operator()(const f32x4 (&acc)[2][2][4][2], const Unit& u, int wr, int wc, int fr, int fq) const {
        asm volatile("" : "+v"(fr), "+v"(fq));
        const int rl0 = wr * 64 + fr; const int col0 = (u.pn & 3) * 256 + wc * 32 + 8 * fq;
#pragma unroll
        for (int ai = 0; ai < 2; ++ai)
#pragma unroll
            for (int m = 0; m < 4; ++m) { const int rl = rl0 + ai * HALF + m * 16; const float w = rl < u.rows ? wl[(size_t)u.e * CAP + u.pos0 + rl] * (Y_SCALE / W2_SCALE) : 0.f;
                unsigned char* rp = Y + (size_t)(u.pm * BM + rl) * D + col0;
#pragma unroll
                for (int bj = 0; bj < 2; ++bj) *(u32x2*)(rp + bj * HALF) = pack8_fp8(acc[ai][bj][m][0] * w, acc[ai][bj][m][1] * w); }
    }
};
}

#define XB_TMO      128
#define XB_XCNT(j)  (256  + 64 * (j))
#define XB_XSUB(j)  (1280 + 64 * (j))
#define XB_XGEN(j)  (2304 + 64 * (j))
#define XB_TOP      3328
#define XB_TOPGEN   3392
#define XCD_BAR_WORDS 3456
#define XB_SPIN_CAP (1u << 18)
__device__ __forceinline__ unsigned xb_ld(unsigned* p)              { return __hip_atomic_load(p, __ATOMIC_RELAXED, __HIP_MEMORY_SCOPE_AGENT); }
__device__ __forceinline__ unsigned xb_add(unsigned* p, unsigned v) { return __hip_atomic_fetch_add(p, v, __ATOMIC_RELAXED, __HIP_MEMORY_SCOPE_AGENT); }
__device__ __forceinline__ unsigned xb_xcc_id() { return (unsigned)__builtin_amdgcn_s_getreg((3 << 11) | 20) & 0xFu; }
#define XB_SPIN(cond, bar) do { unsigned _sp = 0; while (cond) { __builtin_amdgcn_s_sleep(1); \
    if ((++_sp & 255u) == 0u) { if (xb_ld(&(bar)[XB_TMO])) break; if (_sp > XB_SPIN_CAP) { atomicAdd(&(bar)[XB_TMO], 1u); break; } } } } while (0)
struct XcdBarrier { unsigned* bar; unsigned x; volatile LAS unsigned* st; };
__device__ __forceinline__ XcdBarrier xcd_barrier_post(unsigned* bar, volatile LAS unsigned* st) {
    XcdBarrier b; b.bar = bar; b.x = xb_xcc_id(); b.st = st;
    if (threadIdx.x == 0) (void)xb_add(&bar[XB_XCNT(b.x)], 1u);
    return b;
}
__device__ __forceinline__ void xcd_barrier_complete(unsigned* bar, unsigned x, unsigned& nloc, unsigned& nx) {
    const unsigned G = gridDim.x * gridDim.y * gridDim.z;
    unsigned sum, cnt, mine, sp = 0u;
    for (;;) {
        sum = 0u; cnt = 0u; mine = 0u;
#pragma unroll
        for (unsigned j = 0; j < 16; ++j) { const unsigned c = xb_ld(&bar[XB_XCNT(j)]); sum += c; cnt += (c > 0u) ? 1u : 0u; mine = (j == x) ? c : mine; }
        if (sum == G) break;
        __builtin_amdgcn_s_sleep(1);
        if ((++sp & 255u) == 0u) { if (xb_ld(&bar[XB_TMO])) break; if (sp > XB_SPIN_CAP) { atomicAdd(&bar[XB_TMO], 1u); break; } }
    }
    nloc = mine > 0u ? mine : 1u; nx = cnt > 0u ? cnt : 1u;
}
__device__ __forceinline__ void xcd_barrier(const XcdBarrier& b) {
    asm volatile("s_waitcnt vmcnt(0)" ::: "memory");
    __syncthreads();
    if (threadIdx.x == 0) {
        unsigned* bar = b.bar;
        __builtin_amdgcn_s_waitcnt(0);
        unsigned nloc = b.st[0], nx = b.st[1];
        if (nloc == 0u) { xcd_barrier_complete(bar, b.x, nloc, nx); b.st[0] = nloc; b.st[1] = nx; }
        const unsigned old = xb_add(&bar[XB_XSUB(b.x)], 1u);
        const unsigned gen = old / nloc;
        if (old + 1u == (gen + 1u) * nloc) {
            __builtin_amdgcn_fence(__ATOMIC_RELEASE, "agent");
            asm volatile("s_waitcnt vmcnt(0)" ::: "memory");
            const unsigned og = xb_add(&bar[XB_TOP], 1u);
            const unsigned tg = og / nx;
            if (og + 1u == (tg + 1u) * nx) xb_add(&bar[XB_TOPGEN], 1u);
            else XB_SPIN(xb_ld(&bar[XB_TOPGEN]) == tg, bar);
            __builtin_amdgcn_fence(__ATOMIC_ACQUIRE, "agent");
            xb_add(&bar[XB_XGEN(b.x)], 1u);
            asm volatile("s_waitcnt vmcnt(0)" ::: "memory");
        } else {
            XB_SPIN(xb_ld(&bar[XB_XGEN(b.x)]) == gen, bar);
            __builtin_amdgcn_fence(__ATOMIC_ACQUIRE, "agent");
            asm volatile("s_waitcnt vmcnt(0)" ::: "memory");
        }
    }
    __syncthreads();
}

constexpr int NWAVES = 8;
struct Frame {
    LAS unsigned char* lds;
    gu32* ctl;
    int tid, lane, wave;
    int vcu, G;
    const float *x, *g_mix, *w_in, *b_gate, *conv_w, *w_ao, *w_co, *w_out, *g_ffn, *w_rg, *b_rg, *w_re, *b_re, *w1, *w3, *w2, *g_fin;
    float* out;
    bf16 *WinT, *WacT, *WoT, *PROJ, *XN, *X1B; unsigned char* Y; float* irs1;
    unsigned char *W13Q, *W2Q, *X1Q, *HIDQ, *XNQ, *WinQ;
    int* list; float* wl; float* rsl; int* tokinfo; float* WrT;
};
__device__ __forceinline__ float wave_sum(float v) {
#pragma unroll
    for (int o = 1; o < 64; o <<= 1) v += __shfl_xor(v, o);
    return v;
}
__device__ __forceinline__ void tr_item(const float* W, int ldw, int k0, int n0, bf16* WT, int ldt, int drow0, int dcol0, const float* rg, float cs, LAS float* scr, int lane) {
    const int kr = lane >> 3, nc = 4 * (lane & 7);
    f32x4 v[8]; float sc[8];
#pragma unroll
    for (int i = 0; i < 8; ++i) v[i] = __builtin_nontemporal_load((const GAS f32x4*)(W + (size_t)(k0 + 8 * i + kr) * ldw + n0 + nc));
#pragma unroll
    for (int i = 0; i < 8; ++i) sc[i] = rg ? rg[k0 + 8 * i + kr] * cs : cs;
#pragma unroll
    for (int i = 0; i < 8; ++i) { LAS float* d = scr + (8 * i + kr) * 33 + nc; const f32x4 t = v[i] * sc[i]; d[0] = t.x; d[1] = t.y; d[2] = t.z; d[3] = t.w; }
    LDS_WAIT(); asm volatile("" ::: "memory");
    const int c = lane & 7;
#pragma unroll
    for (int j = 0; j < 4; ++j) { const int n = (lane >> 3) + 8 * j; const LAS float* s = scr + (8 * c) * 33 + n;
        v4u o; o.x = pk2(s[0 * 33], s[1 * 33]); o.y = pk2(s[2 * 33], s[3 * 33]); o.z = pk2(s[4 * 33], s[5 * 33]); o.w = pk2(s[6 * 33], s[7 * 33]);
        *(GAS v4u*)(WT + (size_t)(drow0 + n) * ldt + dcol0 + 8 * c) = o; }
    LDS_WAIT(); asm volatile("" ::: "memory");
}
__device__ __forceinline__ void tr_item_q(const float* W, int ldw, int k0, int n0, unsigned char* WT, int ldt, int drow0, int dcol0, const float* rg, float cs, LAS float* scr, int lane) {
    const int kr = lane >> 3, nc = 4 * (lane & 7);
    f32x4 v[8]; float sc[8];
#pragma unroll
    for (int i = 0; i < 8; ++i) v[i] = __builtin_nontemporal_load((const GAS f32x4*)(W + (size_t)(k0 + 8 * i + kr) * ldw + n0 + nc));
#pragma unroll
    for (int i = 0; i < 8; ++i) sc[i] = rg ? rg[k0 + 8 * i + kr] * cs : cs;
#pragma unroll
    for (int i = 0; i < 8; ++i) { LAS float* d = scr + (8 * i + kr) * 33 + nc; const f32x4 t = v[i] * sc[i]; d[0] = t.x; d[1] = t.y; d[2] = t.z; d[3] = t.w; }
    LDS_WAIT(); asm volatile("" ::: "memory");
    const int c = lane & 7;
#pragma unroll
    for (int j = 0; j < 4; ++j) { const int n = (lane >> 3) + 8 * j; const LAS float* s = scr + (8 * c) * 33 + n;
        const f32x4 a = {s[0 * 33], s[1 * 33], s[2 * 33], s[3 * 33]}, b = {s[4 * 33], s[5 * 33], s[6 * 33], s[7 * 33]};
        *(GAS pg8::u32x2*)(WT + (size_t)(drow0 + n) * ldt + dcol0 + 8 * c) = pg8::pack8_fp8(a, b); }
    LDS_WAIT(); asm volatile("" ::: "memory");
}
__device__ __forceinline__ void tr_item_i8(const float* W, int ldw, int k0, int n0, unsigned char* WT, int ldt, int drow0, int dcol0, const float* rg, float cs, LAS float* scr, int lane) {
    const int kr = lane >> 3, nc = 4 * (lane & 7);
    f32x4 v[8]; float sc[8];
#pragma unroll
    for (int i = 0; i < 8; ++i) v[i] = __builtin_nontemporal_load((const GAS f32x4*)(W + (size_t)(k0 + 8 * i + kr) * ldw + n0 + nc));
#pragma unroll
    for (int i = 0; i < 8; ++i) sc[i] = rg ? rg[k0 + 8 * i + kr] * cs : cs;
#pragma unroll
    for (int i = 0; i < 8; ++i) { LAS float* d = scr + (8 * i + kr) * 33 + nc; const f32x4 t = v[i] * sc[i]; d[0] = t.x; d[1] = t.y; d[2] = t.z; d[3] = t.w; }
    LDS_WAIT(); asm volatile("" ::: "memory");
    const int c = lane & 7;
#pragma unroll
    for (int j = 0; j < 4; ++j) { const int n = (lane >> 3) + 8 * j; const LAS float* s = scr + (8 * c) * 33 + n;
        v2u o; o.x = pack4_i8(s[0 * 33], s[1 * 33], s[2 * 33], s[3 * 33]); o.y = pack4_i8(s[4 * 33], s[5 * 33], s[6 * 33], s[7 * 33]);
        *(GAS v2u*)(WT + (size_t)(drow0 + n) * ldt + dcol0 + 8 * c) = o; }
    LDS_WAIT(); asm volatile("" ::: "memory");
}
__device__ __forceinline__ int win_dst(int n) {
    if (n < 256) return n;
    if (n < 512) return PC_Q1 + (n - 256);
    if (n < 768) return PC_Q2 + (n - 512);
    if (n < 1536) { const int c = n - 768; return PC_K + (c >> 6) * 128 + (c & 63); }
    if (n < 2304) { const int c = n - 1536; return PC_K + (c >> 6) * 128 + 64 + (c & 63); }
    if (n < 3072) return PC_BG + (n - 2304);
    if (n < 3840) { const int i = (n - 3072) >> 7, w = (n - 3072) & 127; return 3072 + 256 * i + w; }
    if (n < 4608) { const int i = (n - 3840) >> 7, w = (n - 3840) & 127; return 3072 + 256 * i + 128 + w; }
    return n;
}
__device__ __forceinline__ void p0_prologue(Frame& F) {
    LAS float* scr = (LAS float*)(F.lds + F.wave * 16384);
    const int gw = F.vcu * NWAVES + F.wave, NGW = F.G * NWAVES;
    constexpr int I_IN = (D / 64) * (NPROJ / 32), I_AO = (256 / 64) * (D / 32), I_CO = (768 / 64) * (D / 32), I_O = (D / 64) * (D / 32);
    constexpr int NITEMS = I_IN + I_AO + I_CO + I_O;
    for (int it = gw; it < NITEMS; it += NGW) {
        int r = it;
        if (r < I_IN) { const int nb = r % (NPROJ / 32), kb = r / (NPROJ / 32); const int n0 = 32 * nb;
            tr_item_i8(F.w_in, NPROJ, 64 * kb, n0, (unsigned char*)F.WinT, D, win_dst(n0), 64 * kb, F.g_mix, 127.0f / W8_CLIP, scr, F.lane);
            continue; }
        r -= I_IN;
        if (r < I_AO) { const int nb = r % (D / 32), kb = r / (D / 32); tr_item(F.w_ao, D, 64 * kb, 32 * nb, F.WacT, D, 32 * nb, 64 * kb, nullptr, 1.0f, scr, F.lane); continue; }
        r -= I_AO;
        if (r < I_CO) { const int nb = r % (D / 32), kb = r / (D / 32); tr_item(F.w_co, D, 64 * kb, 32 * nb, F.WacT, D, 32 * nb, 256 + 64 * kb, nullptr, 1.0f, scr, F.lane); continue; }
        r -= I_CO;
        { const int nb = r % (D / 32), kb = r / (D / 32); tr_item_i8(F.w_out, D, 64 * kb, 32 * nb, (unsigned char*)F.WoT, D, 32 * nb, 64 * kb, nullptr, 127.0f / W8_CLIP, scr, F.lane); }
    }
    for (int idx = gw * 64 + F.lane; idx < 48 * D / 2; idx += NGW * 64) { const int c = idx >> 9, k = (idx & (D / 2 - 1)) * 2;
        float w0 = 0.f, w1 = 0.f; if (c < 4) { w0 = F.w_rg[k * 4 + c]; w1 = F.w_rg[(k + 1) * 4 + c]; } else if (c < 36) { w0 = F.w_re[k * 32 + (c - 4)]; w1 = F.w_re[(k + 1) * 32 + (c - 4)]; }
        ((unsigned*)F.WrT)[idx] = pk2(w0 * F.g_ffn[k], w1 * F.g_ffn[k + 1]); }
    for (int m4 = gw * 4; m4 < T; m4 += NGW * 4) {
        f32x4 v[4][4]; float sq[4];
#pragma unroll
        for (int q = 0; q < 4; ++q) { const GAS f32x4* xr = (const GAS f32x4*)(F.x + (size_t)(m4 + q) * D) + F.lane;
#pragma unroll
            for (int j = 0; j < 4; ++j) v[q][j] = __builtin_nontemporal_load(xr + 64 * j); }
#pragma unroll
        for (int q = 0; q < 4; ++q) { float s = 0.f;
#pragma unroll
            for (int j = 0; j < 4; ++j) s += (v[q][j].x * v[q][j].x + v[q][j].y * v[q][j].y) + (v[q][j].z * v[q][j].z + v[q][j].w * v[q][j].w);
            sq[q] = s; }
#pragma unroll
        for (int o = 1; o < 64; o <<= 1) {
#pragma unroll
            for (int q = 0; q < 4; ++q) sq[q] += __shfl_xor(sq[q], o); }
        float mx[4];
#pragma unroll
        for (int q = 0; q < 4; ++q) { float m_ = 0.f;
#pragma unroll
            for (int j = 0; j < 4; ++j) m_ = fmaxf(fmaxf(fmaxf(fabsf(v[q][j].x), fabsf(v[q][j].y)), fmaxf(fabsf(v[q][j].z), fabsf(v[q][j].w))), m_);
            mx[q] = m_; }
#pragma unroll
        for (int o = 1; o < 64; o <<= 1) {
#pragma unroll
            for (int q = 0; q < 4; ++q) mx[q] = fmaxf(mx[q], __shfl_xor(mx[q], o)); }
#pragma unroll
        for (int q = 0; q < 4; ++q) { const float rstd = 1.0f / sqrtf(sq[q] * (1.f / D) + RMS_EPS);
            const float amax = fmaxf(mx[q] * rstd, 1e-20f), sxv = amax * (1.0f / 127.0f), qs = rstd * (127.0f / amax);
            if (F.lane == 0) F.irs1[m4 + q] = sxv;
            GAS unsigned* o4 = (GAS unsigned*)(F.XNQ + (size_t)(m4 + q) * D) + F.lane;
#pragma unroll
            for (int j = 0; j < 4; ++j) o4[64 * j] = pack4_i8(v[q][j].x * qs, v[q][j].y * qs, v[q][j].z * qs, v[q][j].w * qs); }
    }
}

__device__ __forceinline__ void p2_conv(Frame& F, bf16* dummy = nullptr) {
    const int gw = F.vcu * NWAVES + F.wave, NGW = F.G * NWAVES;
    for (int t4 = gw * 4; t4 < T; t4 += NGW * 4) {
        const int s0 = t4 & (SEQ - 1);
        float ssq[4] = {0.f, 0.f, 0.f, 0.f};
#pragma unroll
        for (int it = 0; it < 3; ++it) { const int ch = 4 * F.lane + 256 * it;
            const bf16* up = F.PROJ + (size_t)t4 * PROJ_LD + PC_U + ch; bf16* bp = F.PROJ + (size_t)t4 * PROJ_LD + PC_BG + ch;
            v2u u[6], bg[4];
#pragma unroll
            for (int q = 0; q < 6; ++q) { const int sq = s0 - 1 + q; u[q] = (v2u){0u, 0u}; if (sq >= 0 && sq < SEQ) u[q] = *(const GAS v2u*)(up + (q - 1) * PROJ_LD); }
#pragma unroll
            for (int q = 0; q < 4; ++q) bg[q] = *(const GAS v2u*)(bp + q * PROJ_LD);
            const f32x4 w0 = *(const GAS f32x4*)(F.conv_w + ch), w1 = *(const GAS f32x4*)(F.conv_w + 768 + ch), w2 = *(const GAS f32x4*)(F.conv_w + 1536 + ch);
#pragma unroll
            for (int q = 0; q < 4; ++q) { const v2u um = u[q], u0 = u[q + 1], upl = u[q + 2];
                const float c0 = bflo(bg[q].x) * (w0.x * bflo(um.x) + w1.x * bflo(u0.x) + w2.x * bflo(upl.x));
                const float c1 = bfhi(bg[q].x) * (w0.y * bfhi(um.x) + w1.y * bfhi(u0.x) + w2.y * bfhi(upl.x));
                const float c2 = bflo(bg[q].y) * (w0.z * bflo(um.y) + w1.z * bflo(u0.y) + w2.z * bflo(upl.y));
                const float c3 = bfhi(bg[q].y) * (w0.w * bfhi(um.y) + w1.w * bfhi(u0.y) + w2.w * bfhi(upl.y));
                ssq[q] += (c0 * c0 + c1 * c1) + (c2 * c2 + c3 * c3);
                v2u o; o.x = pk2(c0, c1); o.y = pk2(c2, c3); bf16* dp = dummy ? dummy + (size_t)(t4 + q) * 768 + ch : bp + q * PROJ_LD; *(GAS v2u*)dp = o; } }
#pragma unroll
        for (int o = 1; o < 64; o <<= 1) {
#pragma unroll
            for (int q = 0; q < 4; ++q) ssq[q] += __shfl_xor(ssq[q], o); }
        if (F.lane == 0) {
#pragma unroll
            for (int q = 0; q < 4; ++q) F.irs1[t4 + q] = fmaxf(MERGED_CLIP * sqrtf(ssq[q] * (1.0f / 768.0f)), 1e-20f) * (1.0f / 127.0f); }
    }
}
__device__ __forceinline__ void p2_attn_naive(Frame& F) {
    for (int blk = F.vcu; blk < T / 128; blk += F.G) {
        const int t = blk * 128 + (F.tid & 127), j = F.tid >> 7;
        const int b = t / SEQ, s = t % SEQ;
        float o[64];
#pragma unroll
        for (int e = 0; e < 64; ++e) o[e] = 0.f;
        float mx = -1e30f, l = 0.f;
        for (int g = 0; g < 3; ++g) {
            const int dil = g == 0 ? 1 : (g == 1 ? 4 : 16);
            const int qc = (g == 0 ? PC_Q0 : (g == 1 ? PC_Q1 : PC_Q2)) + 64 * j;
            const float slope2 = exp2f(-8.0f * (float)(4 * g + j + 1) / 12.0f) * LOG2E * (float)dil;
            float q[64];
            { const bf16* qp = F.PROJ + (size_t)t * PROJ_LD + qc;
#pragma unroll
              for (int c = 0; c < 8; ++c) { const v4u w = *(const GAS v4u*)(qp + 8 * c);
#pragma unroll
                  for (int z = 0; z < 4; ++z) { q[8 * c + 2 * z] = bflo(w[z]); q[8 * c + 2 * z + 1] = bfhi(w[z]); } } }
            for (int dl = -64; dl <= 64; ++dl) {
                const int s2 = s + dl * dil;
                if (s2 < 0 || s2 >= SEQ) continue;
                const bf16* kp = F.PROJ + (size_t)(b * SEQ + s2) * PROJ_LD + PC_K + g * 256 + 64 * j;
                float dot = 0.f;
#pragma unroll
                for (int c = 0; c < 8; ++c) { const v4u w = *(const GAS v4u*)(kp + 8 * c);
#pragma unroll
                    for (int z = 0; z < 4; ++z) dot += q[8 * c + 2 * z] * bflo(w[z]) + q[8 * c + 2 * z + 1] * bfhi(w[z]); }
                const float sc = dot - slope2 * (float)(dl < 0 ? -dl : dl);
                const float mn = fmaxf(mx, sc);
                const float alpha = fast_exp2(mx - mn), p = fast_exp2(sc - mn);
                mx = mn; l = l * alpha + p;
                const bf16* vp = kp + (PC_V - PC_K);
#pragma unroll
                for (int c = 0; c < 8; ++c) { const v4u w = *(const GAS v4u*)(vp + 8 * c);
#pragma unroll
                    for (int z = 0; z < 4; ++z) { o[8 * c + 2 * z] = o[8 * c + 2 * z] * alpha + p * bflo(w[z]); o[8 * c + 2 * z + 1] = o[8 * c + 2 * z + 1] * alpha + p * bfhi(w[z]); } }
            }
        }
        const float inv = 1.0f / l;
        bf16* op = F.PROJ + (size_t)t * PROJ_LD + PC_O + 64 * j;
#pragma unroll
        for (int c = 0; c < 8; ++c) { v4u w;
#pragma unroll
            for (int z = 0; z < 4; ++z) w[z] = pk2(o[8 * c + 2 * z] * inv, o[8 * c + 2 * z + 1] * inv);
            *(GAS v4u*)(op + 8 * c) = w; }
    }
}


typedef float f32x16 __attribute__((ext_vector_type(16)));
typedef short bf16x8v __attribute__((ext_vector_type(8)));
typedef short s16x4 __attribute__((ext_vector_type(4)));
typedef short v4i16_t __attribute__((ext_vector_type(4)));
__device__ __forceinline__ int crow(int r, int hi) { return (r & 3) + 8 * (r >> 2) + 4 * hi; }
__device__ __forceinline__ s16x4 tr_read(const LAS unsigned char* p) { return __builtin_bit_cast(s16x4, __builtin_amdgcn_ds_read_tr16_b64_v4i16((LAS v4i16_t*)p)); }
__device__ __forceinline__ void attn_unit(Frame& F, int u, LAS unsigned char* vl, float* lse) {
    const int lane = F.lane, r32 = lane & 31, hi = lane >> 5;
    const int g = u >> 12, rem = u & 4095, j = rem >> 10, st = rem & 1023;
    const int sh = 2 * g, dil = 1 << sh, L = SEQ >> sh;
    const int b = st >> 8, w = st & 255, r = w >> (8 - sh), ti = w & ((256 >> sh) - 1);
    const int i0 = 32 * ti;
    const size_t rowbase = (size_t)b * SEQ + r;
    const int qcol = (g == 0 ? PC_Q0 : (g == 1 ? PC_Q1 : PC_Q2)) + 64 * j;
    const bf16* kbase = F.PROJ + PC_K + g * 256 + 64 * j;
    const float slope2 = exp2f(-8.0f * (float)(4 * g + j + 1) / 12.0f) * LOG2E * (float)dil;
    const size_t qrow = rowbase + (size_t)(i0 + r32) * dil;
    bf16x8v qr[4];
    { const bf16* qp = F.PROJ + qrow * PROJ_LD + qcol + 8 * hi;
#pragma unroll
      for (int d0 = 0; d0 < 4; ++d0) qr[d0] = *(const GAS bf16x8v*)(qp + 16 * d0); }
    f32x16 p[5];
#pragma unroll
    for (int kt = 0; kt < 5; ++kt) {
        int pos = i0 - 64 + 32 * kt + r32; pos = pos < 0 ? 0 : (pos > L - 1 ? L - 1 : pos);
        const bf16* kp = kbase + (rowbase + (size_t)pos * dil) * PROJ_LD + 8 * hi;
        bf16x8v kf[4];
#pragma unroll
        for (int d0 = 0; d0 < 4; ++d0) kf[d0] = *(const GAS bf16x8v*)(kp + 16 * d0);
        f32x16 a = {0.f, 0.f, 0.f, 0.f, 0.f, 0.f, 0.f, 0.f, 0.f, 0.f, 0.f, 0.f, 0.f, 0.f, 0.f, 0.f};
#pragma unroll
        for (int d0 = 0; d0 < 4; ++d0) a = __builtin_amdgcn_mfma_f32_32x32x16_bf16(kf[d0], qr[d0], a, 0, 0, 0);
        p[kt] = a;
    }
    float mloc = -1e30f;
    const float dbase = (float)(4 * hi - r32 - 64);
#pragma unroll
    for (int kt = 0; kt < 5; ++kt)
#pragma unroll
        for (int rr = 0; rr < 16; ++rr) {
            const float d = dbase + (float)(32 * kt + (rr & 3) + 8 * (rr >> 2));
            float sv = p[kt][rr] - slope2 * fabsf(d);
            if (kt == 0) sv = d >= -64.0f ? sv : -1e30f;
            if (kt == 4) sv = d <= 64.0f ? sv : -1e30f;
            p[kt][rr] = sv;
        }
    if (i0 < 64 || i0 + 96 > L) {
#pragma unroll
        for (int kt = 0; kt < 5; ++kt)
#pragma unroll
            for (int rr = 0; rr < 16; ++rr) { const int pos = i0 - 64 + 32 * kt + crow(rr, hi); p[kt][rr] = (pos >= 0 && pos < L) ? p[kt][rr] : -1e30f; }
    }
#pragma unroll
    for (int kt = 0; kt < 5; ++kt)
#pragma unroll
        for (int rr = 0; rr < 16; ++rr) mloc = fmaxf(mloc, p[kt][rr]);
    const float mrow = fmaxf(mloc, __shfl_xor(mloc, 32));
    float lsum = 0.f;
#pragma unroll
    for (int kt = 0; kt < 5; ++kt)
#pragma unroll
        for (int rr = 0; rr < 16; ++rr) { const float e = fast_exp2(p[kt][rr] - mrow); p[kt][rr] = e; lsum += e; }
    const float lrow = lsum + __shfl_xor(lsum, 32);
    bf16x8v pb[5][2];
#pragma unroll
    for (int kt = 0; kt < 5; ++kt)
#pragma unroll
        for (int s2 = 0; s2 < 2; ++s2) { v4u wv;
#pragma unroll
            for (int q = 0; q < 4; ++q) wv[q] = pg8::cvt_pk_bf16(p[kt][8 * s2 + 2 * q], p[kt][8 * s2 + 2 * q + 1]);
            pb[kt][s2] = __builtin_bit_cast(bf16x8v, wv); }
    f32x16 o[2];
#pragma unroll
    for (int db = 0; db < 2; ++db) o[db] = (f32x16){0.f, 0.f, 0.f, 0.f, 0.f, 0.f, 0.f, 0.f, 0.f, 0.f, 0.f, 0.f, 0.f, 0.f, 0.f, 0.f};
    const bf16* vbase = kbase + (PC_V - PC_K);
    const LAS unsigned char* vrd = vl + (4 * hi + ((lane & 15) >> 2)) * 128 + ((lane >> 4) & 1) * 32 + (lane & 3) * 8;
#pragma unroll
    for (int kt = 0; kt < 5; ++kt) {
        v4u vv[4];
#pragma unroll
        for (int i = 0; i < 4; ++i) { int pos = i0 - 64 + 32 * kt + 8 * i + (lane >> 3); pos = pos < 0 ? 0 : (pos > L - 1 ? L - 1 : pos);
            vv[i] = *(const GAS v4u*)(vbase + (rowbase + (size_t)pos * dil) * PROJ_LD + 8 * (lane & 7)); }
        asm volatile("" ::: "memory");
#pragma unroll
        for (int i = 0; i < 4; ++i) *(LAS v4u*)(vl + (8 * i + (lane >> 3)) * 128 + (lane & 7) * 16) = vv[i];
        asm volatile("" ::: "memory");
#pragma unroll
        for (int db = 0; db < 2; ++db)
#pragma unroll
            for (int s2 = 0; s2 < 2; ++s2) {
                const s16x4 lo = tr_read(vrd + (16 * s2) * 128 + db * 64), hh = tr_read(vrd + (16 * s2 + 8) * 128 + db * 64);
                const bf16x8v vf = (bf16x8v){lo[0], lo[1], lo[2], lo[3], hh[0], hh[1], hh[2], hh[3]};
                o[db] = __builtin_amdgcn_mfma_f32_32x32x16_bf16(vf, pb[kt][s2], o[db], 0, 0, 0);
            }
        asm volatile("" ::: "memory");
    }
    const float inv = 1.0f / lrow;
    bf16* op = F.X1B + qrow * 768 + g * 256 + 64 * j + 4 * hi;
#pragma unroll
    for (int db = 0; db < 2; ++db)
#pragma unroll
        for (int rg = 0; rg < 4; ++rg) { v2u wv; wv.x = pg8::cvt_pk_bf16(o[db][4 * rg] * inv, o[db][4 * rg + 1] * inv); wv.y = pg8::cvt_pk_bf16(o[db][4 * rg + 2] * inv, o[db][4 * rg + 3] * inv);
            *(GAS v2u*)(op + 32 * db + 8 * rg) = wv; }
    if (hi == 0) lse[qrow * 12 + g * 4 + j] = mrow + log2f(lrow);
}
struct AttnItem { int g, j, sh, L, c0; size_t rowbase; };
__device__ __forceinline__ AttnItem attn_decode(int it) {
    AttnItem a; a.g = it >> 9; const int rem = it & 511; a.j = rem >> 7; const int sq = rem & 127; const int b = sq >> 5, w = sq & 31;
    a.sh = 2 * a.g; a.L = SEQ >> a.sh; const int r = w >> (5 - a.sh), ci = w & ((32 >> a.sh) - 1); a.c0 = 256 * ci; a.rowbase = (size_t)b * SEQ + r; return a;
}
__device__ __forceinline__ void attn_fetch(Frame& F, const AttnItem& a, v4u (&R)[6]) {
    const unsigned char* base = (const unsigned char*)(F.PROJ + PC_K) + (a.g * 4 + a.j) * 128;
    int tid = F.tid; asm volatile("" : "+v"(tid));
#pragma unroll
    for (int k = 0; k < 6; ++k) { const int id = tid + 512 * k, row = id >> 3, c8 = id & 7;
        int pos = a.c0 - 64 + row; pos = pos < 0 ? 0 : (pos > a.L - 1 ? a.L - 1 : pos);
        R[k] = *(const GAS v4u*)(base + (a.rowbase + ((size_t)pos << a.sh)) * (size_t)(PROJ_LD * 2) + 16 * c8); }
}
__device__ __forceinline__ void attn_commit(Frame& F, const v4u (&R)[6], LAS unsigned char* kimg, LAS unsigned char* vimg) {
    int tid = F.tid; asm volatile("" : "+v"(tid));
#pragma unroll
    for (int k = 0; k < 6; ++k) { const int id = tid + 512 * k, row = id >> 3, c8 = id & 7, c4 = c8 & 3;
        unsigned w[8];
#pragma unroll
        for (int q = 0; q < 4; ++q) { const pg8::f32x2_t lo = __builtin_amdgcn_cvt_pk_f32_fp8((int)R[k][q], false), hi = __builtin_amdgcn_cvt_pk_f32_fp8((int)R[k][q], true);
            w[2 * q] = pg8::cvt_pk_bf16(lo[0], lo[1]); w[2 * q + 1] = pg8::cvt_pk_bf16(hi[0], hi[1]); }
        const int sw = ((row & 2) << 1) | ((row >> 2) & 3);
        LAS unsigned char* img = ((c8 & 4) ? vimg : kimg) + row * 128;
        *(LAS v4u*)(img + (((2 * c4) ^ sw) << 4)) = (v4u){w[0], w[1], w[2], w[3]};
        *(LAS v4u*)(img + (((2 * c4 + 1) ^ sw) << 4)) = (v4u){w[4], w[5], w[6], w[7]}; }
}
__device__ __forceinline__ void p2_attn_v2(Frame& F) {
    LAS unsigned char* kimg = F.lds; LAS unsigned char* vimg = F.lds + 49152;
    float* lse = (float*)F.list;
    const int lane = F.lane, r32 = lane & 31, hi = lane >> 5, w = F.wave;
    const int swk = ((r32 & 2) << 1) | ((r32 >> 2) & 3);
    const LAS unsigned char* kb = kimg + (32 * w + r32) * 128;
    int koff[4];
#pragma unroll
    for (int d0 = 0; d0 < 4; ++d0) koff[d0] = ((2 * d0 + hi) ^ swk) << 4;
    const int qp_ = (lane & 15) >> 2, pp_ = lane & 3, gh = (lane >> 4) & 1;
    const LAS unsigned char* vad[2][2];
#pragma unroll
    for (int a = 0; a < 2; ++a)
#pragma unroll
        for (int db = 0; db < 2; ++db) { const int sw = ((qp_ & 2) << 1) | ((2 * a + hi) & 3); const int cb = 4 * db + 2 * gh + (pp_ >> 1);
            vad[a][db] = vimg + (32 * w + 8 * a + 4 * hi + qp_) * 128 + ((cb ^ sw) << 4) + (pp_ & 1) * 8; }
    int it = F.vcu;
    v4u R[6];
    bf16x8v qr[4];
#define ATTN_LOAD_Q(item) do { const AttnItem aq_ = attn_decode(item); const int qcol_ = (aq_.g == 0 ? PC_Q0 : (aq_.g == 1 ? PC_Q1 : PC_Q2)) + 64 * aq_.j; \
        const bf16* qp_g = F.PROJ + (aq_.rowbase + ((size_t)(aq_.c0 + 32 * w + r32) << aq_.sh)) * PROJ_LD + qcol_ + 8 * hi; \
        _Pragma("unroll") for (int d0 = 0; d0 < 4; ++d0) qr[d0] = *(const GAS bf16x8v*)(qp_g + 16 * d0); } while (0)
    if (it < 1536) { const AttnItem a0 = attn_decode(it); attn_fetch(F, a0, R); ATTN_LOAD_Q(it); }
    for (; it < 1536; it += F.G) {
        const AttnItem a = attn_decode(it);
        const int dil = 1 << a.sh, L = a.L, i0 = a.c0 + 32 * w;
        const float slope2 = exp2f(-8.0f * (float)(4 * a.g + a.j + 1) / 12.0f) * LOG2E * (float)dil;
        const size_t qrow = a.rowbase + (size_t)(i0 + r32) * dil;
        attn_commit(F, R, kimg, vimg);
        asm volatile("s_waitcnt lgkmcnt(0)" ::: "memory");
        __builtin_amdgcn_s_barrier(); asm volatile("" ::: "memory");
        if (it + F.G < 1536) { const AttnItem an = attn_decode(it + F.G); attn_fetch(F, an, R); }
        f32x16 p[5];
#pragma unroll
        for (int kt = 0; kt < 5; ++kt) {
            bf16x8v kf[4];
#pragma unroll
            for (int d0 = 0; d0 < 4; ++d0) kf[d0] = *(const LAS bf16x8v*)(kb + kt * 4096 + koff[d0]);
            f32x16 acc = {0.f, 0.f, 0.f, 0.f, 0.f, 0.f, 0.f, 0.f, 0.f, 0.f, 0.f, 0.f, 0.f, 0.f, 0.f, 0.f};
#pragma unroll
            for (int d0 = 0; d0 < 4; ++d0) acc = __builtin_amdgcn_mfma_f32_32x32x16_bf16(kf[d0], qr[d0], acc, 0, 0, 0);
            p[kt] = acc;
        }
        if (it + F.G < 1536) ATTN_LOAD_Q(it + F.G);
        float mloc = -1e30f;
        float dbase = (float)(4 * hi - r32 - 64);
        asm volatile("" : "+v"(dbase));
#pragma unroll
        for (int kt = 0; kt < 5; ++kt)
#pragma unroll
            for (int rr = 0; rr < 16; ++rr) {
                const float d = dbase + (float)(32 * kt + (rr & 3) + 8 * (rr >> 2));
                float sv = p[kt][rr] - slope2 * fabsf(d);
                if (kt == 0) sv = d >= -64.0f ? sv : -1e30f;
                if (kt == 4) sv = d <= 64.0f ? sv : -1e30f;
                p[kt][rr] = sv;
            }
        if (i0 < 64 || i0 + 96 > L) {
#pragma unroll
            for (int kt = 0; kt < 5; ++kt)
#pragma unroll
                for (int rr = 0; rr < 16; ++rr) { const int pos = i0 - 64 + 32 * kt + crow(rr, hi); p[kt][rr] = (pos >= 0 && pos < L) ? p[kt][rr] : -1e30f; }
        }
#pragma unroll
        for (int kt = 0; kt < 5; ++kt)
#pragma unroll
            for (int rr = 0; rr < 16; ++rr) mloc = fmaxf(mloc, p[kt][rr]);
        const float mrow = fmaxf(mloc, __shfl_xor(mloc, 32));
        float lsum = 0.f;
#pragma unroll
        for (int kt = 0; kt < 5; ++kt)
#pragma unroll
            for (int rr = 0; rr < 16; ++rr) { const float e = fast_exp2(p[kt][rr] - mrow); p[kt][rr] = e; lsum += e; }
        const float lrow = lsum + __shfl_xor(lsum, 32);
        bf16x8v pb[5][2];
#pragma unroll
        for (int kt = 0; kt < 5; ++kt)
#pragma unroll
            for (int s2 = 0; s2 < 2; ++s2) { v4u wv;
#pragma unroll
                for (int q = 0; q < 4; ++q) wv[q] = pg8::cvt_pk_bf16(p[kt][8 * s2 + 2 * q], p[kt][8 * s2 + 2 * q + 1]);
                pb[kt][s2] = __builtin_bit_cast(bf16x8v, wv); }
        f32x16 o[2];
#pragma unroll
        for (int db = 0; db < 2; ++db) o[db] = (f32x16){0.f, 0.f, 0.f, 0.f, 0.f, 0.f, 0.f, 0.f, 0.f, 0.f, 0.f, 0.f, 0.f, 0.f, 0.f, 0.f};
#pragma unroll
        for (int kt = 0; kt < 5; ++kt)
#pragma unroll
            for (int db = 0; db < 2; ++db)
#pragma unroll
                for (int s2 = 0; s2 < 2; ++s2) {
                    const s16x4 lo = tr_read(vad[0][db] + kt * 4096 + s2 * 2048), hh = tr_read(vad[1][db] + kt * 4096 + s2 * 2048);
                    const bf16x8v vf = (bf16x8v){lo[0], lo[1], lo[2], lo[3], hh[0], hh[1], hh[2], hh[3]};
                    o[db] = __builtin_amdgcn_mfma_f32_32x32x16_bf16(vf, pb[kt][s2], o[db], 0, 0, 0);
                }
        const float inv = 1.0f / lrow;
        bf16* op = F.X1B + qrow * 768 + a.g * 256 + 64 * a.j + 4 * hi;
#pragma unroll
        for (int db = 0; db < 2; ++db)
#pragma unroll
            for (int rg = 0; rg < 4; ++rg) { v2u wv; wv.x = pg8::cvt_pk_bf16(o[db][4 * rg] * inv, o[db][4 * rg + 1] * inv); wv.y = pg8::cvt_pk_bf16(o[db][4 * rg + 2] * inv, o[db][4 * rg + 3] * inv);
                *(GAS v2u*)(op + 32 * db + 8 * rg) = wv; }
        if (hi == 0) lse[qrow * 12 + a.g * 4 + a.j] = mrow + log2f(lrow);
        asm volatile("s_waitcnt lgkmcnt(0)" ::: "memory");
        __builtin_amdgcn_s_barrier(); asm volatile("" ::: "memory");
    }
#undef ATTN_LOAD_Q
    asm volatile("s_waitcnt vmcnt(0)" ::: "memory");
    __syncthreads();
}
__device__ __forceinline__ void p2_attn_mfma(Frame& F) {
    LAS unsigned char* vl = F.lds + F.wave * 4096;
    float* lse = (float*)F.list;
    const int gw = F.vcu * NWAVES + F.wave, NGW = F.G * NWAVES;
    for (int rep_ = 0; rep_ < 1 + ((REPEAT_MASK >> 2) & 1); ++rep_)
    for (int u = gw; u < 3 * 4096; u += NGW) attn_unit(F, u, vl, lse);
}
__device__ __forceinline__ void p3_merge(Frame& F) {
    const float* lse = (const float*)F.list;
    const int gw = F.vcu * NWAVES + F.wave, NGW = F.G * NWAVES;
    const int j = F.lane >> 4;
    for (int t4 = gw * 4; t4 < T; t4 += NGW * 4) {
        float l[4][3]; v2u p[4][3];
#pragma unroll
        for (int q = 0; q < 4; ++q) { const float* lp = lse + (size_t)(t4 + q) * 12 + j; const bf16* pp = F.X1B + (size_t)(t4 + q) * 768 + 4 * F.lane;
#pragma unroll
            for (int g = 0; g < 3; ++g) { l[q][g] = lp[4 * g]; p[q][g] = *(const GAS v2u*)(pp + 256 * g); } }
#pragma unroll
        for (int q = 0; q < 4; ++q) {
            const float mx = fmaxf(l[q][0], fmaxf(l[q][1], l[q][2]));
            const float e0 = fast_exp2(l[q][0] - mx), e1 = fast_exp2(l[q][1] - mx), e2 = fast_exp2(l[q][2] - mx);
            const float inv = 1.0f / (e0 + e1 + e2);
            const float w0 = e0 * inv, w1 = e1 * inv, w2 = e2 * inv;
            const v2u a = p[q][0], b = p[q][1], c = p[q][2];
            v2u o; o.x = pk2(w0 * bflo(a.x) + w1 * bflo(b.x) + w2 * bflo(c.x), w0 * bfhi(a.x) + w1 * bfhi(b.x) + w2 * bfhi(c.x));
            o.y = pk2(w0 * bflo(a.y) + w1 * bflo(b.y) + w2 * bflo(c.y), w0 * bfhi(a.y) + w1 * bfhi(b.y) + w2 * bfhi(c.y));
            *(GAS v2u*)(F.PROJ + (size_t)(t4 + q) * PROJ_LD + 4 * F.lane + PC_O) = o;
        }
    }
}

__device__ __forceinline__ void p5_route(Frame& F) {
    LAS float* scr = (LAS float*)(F.lds + F.wave * 16384);
    const int gw = F.vcu * NWAVES + F.wave, NGW = F.G * NWAVES;
    {
        constexpr int PER_E = 256 * 2;
        for (int rep_ = 0; rep_ < 1 + ((REPEAT_MASK >> 6) & 1); ++rep_)
        for (int it = gw; it < NEXP * PER_E; it += NGW) {
            const int e = it / PER_E; int r = it % PER_E;
            const int which = r >> 8; r &= 255; const int nb = r & 15, kb = r >> 4; const int n0 = 32 * nb;
            const float* W = (which ? F.w3 : F.w1) + (size_t)e * D * FF;
            tr_item_q(W, FF, 64 * kb, n0, F.W13Q, D, e * 1024 + 256 * (n0 >> 7) + (n0 & 127) + 128 * which, 64 * kb, F.g_ffn, W13_SCALE, scr, F.lane);
        }
    }
    LAS unsigned* hist = (LAS unsigned*)(F.lds + L_HIST);
    LAS unsigned* lbase = (LAS unsigned*)(F.lds + L_LBASE);
    LAS unsigned* rec = (LAS unsigned*)(F.lds + L_REC);
    if (F.tid < 128) rec[F.tid * 8 + 7] = 0xffffffffu;
    __syncthreads();
    {
        constexpr int WROW = 2064, WIMG = 48 * WROW;
        LAS unsigned char* wimg = F.lds;
        for (int q = F.wave; q < 96; q += NWAVES)
            __builtin_amdgcn_global_load_lds((const unsigned*)((const char*)F.WrT + (size_t)(q >> 1) * 2048 + (q & 1) * 1024 + F.lane * 16), (LAS unsigned*)(wimg + (q >> 1) * WROW + (q & 1) * 1024), 16, 0, 0);
        VM_WAIT(); __syncthreads();
        LAS float* lg = (LAS float*)(F.lds + ((WIMG + 255) & ~255) + F.wave * 3328);
        const int row = F.lane & 15, kq = F.lane >> 4;
        for (int tile = gw; tile < T / 16; tile += NGW) {
            const int t0 = tile * 16;
            const bf16* xp = F.X1B + (size_t)(t0 + row) * D + 8 * kq;
            const LAS unsigned char* wp = wimg + row * WROW + 16 * kq;
            pg8::f32x4 a0 = {0.f, 0.f, 0.f, 0.f}, a1 = a0, a2 = a0; float ss = 0.f;
            for (int rep_ = 0; rep_ < 1 + ((REPEAT_MASK >> 11) & 1); ++rep_) {
            asm volatile("" :: "v"(a0), "v"(a1), "v"(a2), "v"(ss));
            a0 = (pg8::f32x4){0.f, 0.f, 0.f, 0.f}; a1 = a0; a2 = a0; ss = 0.f;
#pragma unroll 8
            for (int c = 0; c < 32; ++c) {
                const v4u xr_ = *(const GAS v4u*)(xp + 32 * c);
                const pg8::bf16x8 xa = __builtin_bit_cast(pg8::bf16x8, xr_);
                const pg8::bf16x8 w0 = *(const LAS pg8::bf16x8*)(wp + 64 * c), w1 = *(const LAS pg8::bf16x8*)(wp + 16 * WROW + 64 * c), w2 = *(const LAS pg8::bf16x8*)(wp + 32 * WROW + 64 * c);
#pragma unroll
                for (int z = 0; z < 4; ++z) { const float lo = bflo(xr_[z]), hi_ = bfhi(xr_[z]); ss += lo * lo + hi_ * hi_; }
                a0 = __builtin_amdgcn_mfma_f32_16x16x32_bf16(xa, w0, a0, 0, 0, 0); a1 = __builtin_amdgcn_mfma_f32_16x16x32_bf16(xa, w1, a1, 0, 0, 0); a2 = __builtin_amdgcn_mfma_f32_16x16x32_bf16(xa, w2, a2, 0, 0, 0);
            }
            }
            ss += __shfl_xor(ss, 16); ss += __shfl_xor(ss, 32);
            const float rstd = 1.0f / sqrtf(ss * (1.f / D) + RMS_EPS);
#pragma unroll
            for (int q = 0; q < 4; ++q) { const int tok = 4 * kq + q; lg[tok * 49 + row] = a0[q]; lg[tok * 49 + 16 + row] = a1[q]; lg[tok * 49 + 32 + row] = a2[q]; }
            if (kq == 0) lg[16 * 49 + row] = rstd;
            LDS_WAIT(); asm volatile("" ::: "memory");
            if (F.lane < 16) {
                const int t = t0 + F.lane; const LAS float* lr = lg + F.lane * 49; const float rs = lg[16 * 49 + F.lane];
                float c[4];
#pragma unroll
                for (int q = 0; q < 4; ++q) c[q] = lr[q] * rs + F.b_rg[q];
                int gi = 0; float cm = c[0];
#pragma unroll
                for (int q = 1; q < 4; ++q) if (c[q] > cm) { cm = c[q]; gi = q; }
                float den = 0.f;
#pragma unroll
                for (int q = 0; q < 4; ++q) den += expf(c[q] - cm);
                const float pg = 1.0f / den;
                float f[8];
#pragma unroll
                for (int q = 0; q < 8; ++q) f[q] = lr[4 + 8 * gi + q] * rs + F.b_re[8 * gi + q];
                int i0 = 0; float f0 = f[0];
#pragma unroll
                for (int q = 1; q < 8; ++q) if (f[q] > f0) { f0 = f[q]; i0 = q; }
                int i1 = -1; float f1 = -3.0e38f;
#pragma unroll
                for (int q = 0; q < 8; ++q) if (q != i0 && f[q] > f1) { f1 = f[q]; i1 = q; }
                const float dd = expf(f1 - f0);
                const float w0 = pg / (1.0f + dd), w1 = pg * dd / (1.0f + dd);
                const int e0 = 8 * gi + i0, e1 = 8 * gi + i1;
                const unsigned r0 = __hip_atomic_fetch_add(hist + e0, 1u, __ATOMIC_RELAXED, __HIP_MEMORY_SCOPE_WORKGROUP);
                const unsigned r1 = __hip_atomic_fetch_add(hist + e1, 1u, __ATOMIC_RELAXED, __HIP_MEMORY_SCOPE_WORKGROUP);
                LAS unsigned* rc = rec + (F.wave * 16 + F.lane) * 8;
                rc[0] = (unsigned)e0; rc[1] = r0; rc[2] = __builtin_bit_cast(unsigned, w0); rc[3] = (unsigned)e1; rc[4] = r1; rc[5] = __builtin_bit_cast(unsigned, w1); rc[6] = __builtin_bit_cast(unsigned, rs); rc[7] = (unsigned)t;
            }
            LDS_WAIT(); asm volatile("" ::: "memory");
        }
    }
    __syncthreads();
    if (F.tid < NEXP) { const unsigned hh = hist[F.tid]; lbase[F.tid] = hh ? __hip_atomic_fetch_add((unsigned*)(F.ctl + CW_CNT + 64 * F.tid), hh, RLX_AGENT) : 0u; }
    __syncthreads();
    if (F.tid < 128) {
        const LAS unsigned* rc = rec + F.tid * 8;
        const unsigned t = rc[7];
        if (t != 0xffffffffu) {
            const int e0 = (int)rc[0], e1 = (int)rc[3];
            const int p0 = (int)(lbase[e0] + rc[1]), p1 = (int)(lbase[e1] + rc[4]);
            const float rstd = __builtin_bit_cast(float, rc[6]);
            F.list[(size_t)e0 * CAP + p0] = (int)t; F.wl[(size_t)e0 * CAP + p0] = __builtin_bit_cast(float, rc[2]); F.rsl[(size_t)e0 * CAP + p0] = rstd;
            F.list[(size_t)e1 * CAP + p1] = (int)t; F.wl[(size_t)e1 * CAP + p1] = __builtin_bit_cast(float, rc[5]); F.rsl[(size_t)e1 * CAP + p1] = rstd;
            *((GAS v4i*)F.tokinfo + t) = (v4i){e0, p0, e1, p1};
        }
    }
}

__device__ __forceinline__ void moe_prefix(Frame& F, int& cnt_e, int& excl, int& incl) {
    int c = 0; if (F.lane < NEXP) { c = (int)__hip_atomic_load((unsigned*)(F.ctl + CW_CNT + 64 * F.lane), RLX_AGENT); if (c > CAP) c = CAP; }
    int v = (c + 255) >> 8;
#pragma unroll
    for (int o = 1; o < 32; o <<= 1) { const int t = __shfl_up(v, o); if ((F.lane & 31) >= o) v += t; }
    cnt_e = c; incl = v; excl = v - ((c + 255) >> 8);
}
__device__ __forceinline__ int moe_tables(Frame& F, bool want_gather) {
    LAS int* cntl = (LAS int*)(F.lds + L_CNT);
    LAS int* tpre = (LAS int*)(F.lds + L_TPRE);
    LAS int* nu = (LAS int*)(F.lds + L_NU);
    LAS int* utab = (LAS int*)(F.lds + L_UTAB);
    LAS int* gtab = (LAS int*)(F.lds + L_GTAB);
    if (F.wave == 0) {
        int c, excl, incl; moe_prefix(F, c, excl, incl);
        if (F.lane < NEXP) { cntl[F.lane] = c; tpre[F.lane] = excl; }
        const int total = __shfl(incl, NEXP - 1);
        if (F.lane == 0) tpre[NEXP] = total;
        const int nunits = total * 4; int n = 0;
        for (int i = 0; i < MAXU; ++i) { const int L = i * F.G + F.vcu; if (L >= nunits) break;
            const int rt = L >> 2, pnl = L & 3;
            const unsigned long long hit = __ballot(F.lane < NEXP && excl <= rt && rt < incl);
            const int e = __builtin_ctzll(hit);
            const int ex = __shfl(excl, e), ce = __shfl(c, e);
            const int pos0 = (rt - ex) * 256; int rows = ce - pos0; if (rows > 256) rows = 256;
            if (F.lane == 0) { utab[i * 8 + 0] = rt; utab[i * 8 + 1] = e * 4 + pnl; utab[i * 8 + 2] = e; utab[i * 8 + 3] = pos0; utab[i * 8 + 4] = rows; }
            n = i + 1; }
        if (F.lane == 0) nu[0] = n;
    }
    __syncthreads();
    const int n = nu[0];
    if (want_gather) {
        for (int idx = F.tid; idx < n * 256; idx += NWAVES * 64) { const int i = idx >> 8, r = idx & 255; const int e = utab[i * 8 + 2], pos0 = utab[i * 8 + 3], rows = utab[i * 8 + 4];
            gtab[idx] = r < rows ? F.list[(size_t)e * CAP + pos0 + r] : 0; }
        __syncthreads();
    }
    return __builtin_amdgcn_readfirstlane(n);
}

__device__ __forceinline__ void p7_w2_copy(Frame& F, int n_mine) {
    const LAS int* tpre = (const LAS int*)(F.lds + L_TPRE);
    const int nunits = tpre[NEXP] * 4, full = nunits / F.G, rem = nunits - full * F.G;
    int nidle = F.G - rem, rank = F.vcu - rem;
    if (rem == 0 || nidle < 64) { nidle = F.G; rank = F.vcu; }
    if (rank < 0) return;
    (void)n_mine;
    LAS float* scr = (LAS float*)(F.lds + F.wave * 16384);
    for (int it = rank * NWAVES + F.wave; it < NEXP * 256; it += nidle * NWAVES) {
        const int e = it >> 8, r = it & 255; const int nb = r & 31, kb = r >> 5;
        tr_item_q(F.w2 + (size_t)e * FF * D, D, 64 * kb, 32 * nb, F.W2Q, FF, e * 1024 + 32 * nb, 64 * kb, nullptr, W2_SCALE, scr, F.lane);
    }
}
__device__ __forceinline__ void p8_final(Frame& F) {
    LAS int* cntl = (LAS int*)(F.lds + L_CNT);
    LAS int* tpre = (LAS int*)(F.lds + L_TPRE);
    if (F.wave == 0) { int c, excl, incl; moe_prefix(F, c, excl, incl); if (F.lane < NEXP) { cntl[F.lane] = c; tpre[F.lane] = excl; } if (F.lane == NEXP - 1) tpre[NEXP] = incl; }
    __syncthreads();
    const int gw = F.vcu * NWAVES + F.wave, NGW = F.G * NWAVES;
    f32x4 gf[4];
#pragma unroll
    for (int j = 0; j < 4; ++j) gf[j] = *((const GAS f32x4*)F.g_fin + F.lane + 64 * j);
    v4i ti[4];
    { const int t0 = gw * 4; if (t0 < T) {
#pragma unroll
        for (int q = 0; q < 4; ++q) ti[q] = *((const GAS v4i*)F.tokinfo + t0 + q); } }
    for (int t4 = gw * 4; t4 < T; t4 += NGW * 4) {
        v2u xb[4][4]; unsigned ya[4][4], yb[4][4];
#pragma unroll
        for (int q = 0; q < 4; ++q) { const GAS v2u* xr = (const GAS v2u*)(F.X1B + (size_t)(t4 + q) * D) + F.lane;
#pragma unroll
            for (int j = 0; j < 4; ++j) xb[q][j] = xr[64 * j]; }
#pragma unroll
        for (int q = 0; q < 4; ++q) {
            const size_t s0 = (size_t)tpre[ti[q].x] * 256 + ti[q].y, s1 = (size_t)tpre[ti[q].z] * 256 + ti[q].w;
            const GAS unsigned* y0 = (const GAS unsigned*)(F.Y + s0 * D) + F.lane; const GAS unsigned* y1 = (const GAS unsigned*)(F.Y + s1 * D) + F.lane;
#pragma unroll
            for (int j = 0; j < 4; ++j) { ya[q][j] = y0[64 * j]; yb[q][j] = y1[64 * j]; }
        }
        { const int tn = t4 + NGW * 4; if (tn < T) {
#pragma unroll
            for (int q = 0; q < 4; ++q) ti[q] = *((const GAS v4i*)F.tokinfo + tn + q); } }
        f32x4 z[4][4]; float sq[4];
#pragma unroll
        for (int q = 0; q < 4; ++q) {
#pragma unroll
            for (int j = 0; j < 4; ++j) { const v2u xb_ = xb[q][j]; const f32x4 xv = {bflo(xb_.x), bfhi(xb_.x), bflo(xb_.y), bfhi(xb_.y)}; const unsigned a = ya[q][j], b = yb[q][j];
                const pg8::f32x2_t a01 = __builtin_amdgcn_cvt_pk_f32_fp8((int)a, false), a23 = __builtin_amdgcn_cvt_pk_f32_fp8((int)a, true), b01 = __builtin_amdgcn_cvt_pk_f32_fp8((int)b, false), b23 = __builtin_amdgcn_cvt_pk_f32_fp8((int)b, true);
                z[q][j].x = xv.x + (a01[0] + b01[0]) * (1.0f / Y_SCALE); z[q][j].y = xv.y + (a01[1] + b01[1]) * (1.0f / Y_SCALE); z[q][j].z = xv.z + (a23[0] + b23[0]) * (1.0f / Y_SCALE); z[q][j].w = xv.w + (a23[1] + b23[1]) * (1.0f / Y_SCALE); }
        }
#pragma unroll
        for (int q = 0; q < 4; ++q) { float ss = 0.f;
#pragma unroll
            for (int j = 0; j < 4; ++j) ss += (z[q][j].x * z[q][j].x + z[q][j].y * z[q][j].y) + (z[q][j].z * z[q][j].z + z[q][j].w * z[q][j].w);
            sq[q] = ss; }
#pragma unroll
        for (int o = 1; o < 64; o <<= 1) {
#pragma unroll
            for (int q = 0; q < 4; ++q) sq[q] += __shfl_xor(sq[q], o); }
#pragma unroll
        for (int q = 0; q < 4; ++q) { const float rstd = 1.0f / sqrtf(sq[q] * (1.f / D) + RMS_EPS);
            GAS f32x4* xr = (GAS f32x4*)(F.out + (size_t)(t4 + q) * D) + F.lane;
#pragma unroll
            for (int j = 0; j < 4; ++j) __builtin_nontemporal_store(z[q][j] * rstd * gf[j], xr + 64 * j); }
    }
}

constexpr int N_PHASES = 10;
struct Args { const float* in[17]; float* out; unsigned char* ws; int ph_lo, ph_hi, li, pad; };
__global__ void __launch_bounds__(NWAVES * 64, 2) fwd_kernel(Args args) {
    extern __shared__ __attribute__((aligned(16))) unsigned char lds[];
    Frame F;
    F.lds = (LAS unsigned char*)lds;
    F.tid = threadIdx.x; F.lane = F.tid & 63; F.wave = __builtin_amdgcn_readfirstlane(F.tid >> 6);
    F.G = gridDim.x; { const int bx = blockIdx.x; F.vcu = (F.G % 8 == 0) ? (bx % 8) * (F.G / 8) + bx / 8 : bx; }
    unsigned char* ws = args.ws;
    F.ctl = (gu32*)(ws + WS_CTL);
    F.x = args.in[0]; F.g_mix = args.in[1]; F.w_in = args.in[2]; F.b_gate = args.in[3]; F.conv_w = args.in[4]; F.w_ao = args.in[5]; F.w_co = args.in[6]; F.w_out = args.in[7];
    F.g_ffn = args.in[8]; F.w_rg = args.in[9]; F.b_rg = args.in[10]; F.w_re = args.in[11]; F.b_re = args.in[12]; F.w1 = args.in[13]; F.w3 = args.in[14]; F.w2 = args.in[15]; F.g_fin = args.in[16];
    F.out = args.out;
    F.WinT = (bf16*)(ws + WS_WIN); F.WacT = (bf16*)(ws + WS_WAC); F.WoT = (bf16*)(ws + WS_WO); F.W13Q = ws + WS_W13; F.W2Q = ws + WS_W2; F.X1Q = ws + WS_X1Q; F.HIDQ = ws + WS_HID; F.XNQ = (unsigned char*)args.out + 64 * MiB; F.WinQ = ws + WS_WINQ;
    F.PROJ = (bf16*)(ws + WS_PROJ); F.XN = (bf16*)args.out; F.X1B = (bf16*)(ws + WS_X1B); F.Y = ws + WS_Y; F.irs1 = (float*)(ws + WS_IRS1);
    F.list = (int*)(ws + WS_LIST); F.wl = (float*)(ws + WS_WL); F.rsl = (float*)(ws + WS_RSL); F.tokinfo = (int*)(ws + WS_TOKINFO); F.WrT = (float*)(ws + WS_WRT);
    for (int u = F.tid; u < (LDS_ZERO_END - L_MISC) / 4; u += NWAVES * 64) ((LAS unsigned*)(F.lds + L_MISC))[u] = 0u;
    __syncthreads();
    volatile LAS unsigned* MISC = (volatile LAS unsigned*)(F.lds + L_MISC);
    XcdBarrier bar; bar.bar = (unsigned*)(F.ctl + CW_BAR); bar.x = 0; bar.st = nullptr;
    if (MK_N_LAUNCHES == 1) bar = xcd_barrier_post((unsigned*)(F.ctl + CW_BAR), MISC + 8);
#define GRID_BAR() do { if (MK_N_LAUNCHES == 1) xcd_barrier(bar); } while (0)
    const int lo = args.ph_lo, hi = args.ph_hi;
#ifndef PHASE_MASK
#define PHASE_MASK 0x3ff
#endif
#define IN(k) (((PHASE_MASK >> (k)) & 1) && lo <= (k) && (k) < hi)
#define BOTH(k) (IN(k) && IN((k) + 1))

    if (IN(0)) { TWICE(0, p0_prologue(F);); if (BOTH(0)) GRID_BAR(); }
    if (IN(1)) {
        TWICE(1,
        {
            pg8::Gemm g{(const bf16*)F.XNQ, (const bf16*)F.WinT, D / 2, D / 2, D / 2}; pg8::StaticOrder S; S.init(T, NPROJ, F.G, (int)blockIdx.x);
            pg8::EpiProjI8 E{F.PROJ, F.b_gate, F.irs1};
            pg8::gemm_phase<pg8::EpiProjI8, pg8::StaticOrder, true, false, 2>(F.lds, g, S, E);
        }
        );
        if (BOTH(1)) GRID_BAR();
    }
    if (IN(2)) {
#if defined(ATTN_NAIVE)
        p2_conv(F); p2_attn_naive(F);
#else
        p2_conv(F); if ((REPEAT_MASK >> 10) & 1) p2_conv(F, (bf16*)F.out);
#if defined(ATTN_V1)
        p2_attn_mfma(F);
#else
        p2_attn_v2(F);
#endif
#endif
        if (BOTH(2)) GRID_BAR(); }
    if (IN(3)) {
#if !defined(ATTN_NAIVE)
        TWICE(3, p3_merge(F););
#endif
        if (BOTH(3)) GRID_BAR(); }
    if (IN(4)) {
        TWICE(4,
        pg8::Gemm g{F.PROJ + PC_O, F.WacT, D, PROJ_LD, D}; pg8::StaticOrder S; S.init(T, D, F.G, (int)blockIdx.x);
        pg8::EpiMerged E{F.PROJ, F.irs1};
        pg8::gemm_phase<pg8::EpiMerged, pg8::StaticOrder, true, false>(F.lds, g, S, E);
        );
        if (BOTH(4)) GRID_BAR();
    }
    if (IN(5)) {
        TWICE(5,
        pg8::Gemm g{(const bf16*)((const unsigned char*)F.PROJ + 2048), F.WoT, D / 2, PROJ_LD, D / 2}; pg8::StaticOrder S; S.init(T, D, F.G, (int)blockIdx.x);
        pg8::EpiOut E{F.x, F.X1B, F.X1Q, F.irs1};
        pg8::gemm_phase<pg8::EpiOut, pg8::StaticOrder, EPI_ALIGN_OUT, false, 2>(F.lds, g, S, E);
        );
        if (BOTH(5)) GRID_BAR();
    }
    if (IN(6)) { p5_route(F); if (BOTH(6)) GRID_BAR(); }
    if (IN(7)) {
        TWICE(7,
        const int n = moe_tables(F, true);
        pg8::Gemm g{(const bf16*)F.X1Q, (const bf16*)F.W13Q, D / 2, D / 2, D / 2}; pg8::MoeOrder S{(const LAS int*)(F.lds + L_UTAB), (const LAS int*)(F.lds + L_GTAB), n};
        pg8::EpiHid E{F.HIDQ, F.rsl};
        pg8::gemm_phase<pg8::EpiHid, pg8::MoeOrder, true, true, true>(F.lds, g, S, E);
        );
        p7_w2_copy(F, 0);
        if (BOTH(7)) GRID_BAR();
    }
    if (IN(8)) {
        TWICE(8,
        const int n = moe_tables(F, false);
        pg8::Gemm g{(const bf16*)F.HIDQ, (const bf16*)F.W2Q, FF / 2, FF / 2, FF / 2}; pg8::MoeOrder S{(const LAS int*)(F.lds + L_UTAB), (const LAS int*)(F.lds + L_GTAB), n};
        pg8::EpiY E{F.Y, F.wl};
        pg8::gemm_phase<pg8::EpiY, pg8::MoeOrder, true, false, true>(F.lds, g, S, E);
        );
        if (BOTH(8)) GRID_BAR();
    }
    if (IN(9)) { TWICE(9, p8_final(F);); }
#undef IN
#undef BOTH
#undef GRID_BAR
}

extern "C" void kernel_launch(void* const* d_in, const int* in_sizes, int n_in, void* d_out, int out_size, void* d_ws, size_t ws_size, hipStream_t stream) {
    static int grid = 0;
    if (grid == 0) {
        if (n_in != 17 || in_sizes[0] != T * D || out_size != T * D || ws_size < WS_END) { fprintf(stderr, "kernel_launch: unexpected shapes (n_in %d, in0 %d, out %d, ws %zu)\n", n_in, n_in > 0 ? in_sizes[0] : -1, out_size, ws_size); grid = -1; return; }
        int dev = 0, cus = 0, per_cu = 0;
        if (hipGetDevice(&dev) != hipSuccess || hipDeviceGetAttribute(&cus, hipDeviceAttributeMultiprocessorCount, dev) != hipSuccess) { grid = -1; return; }
        if (hipFuncSetAttribute((const void*)fwd_kernel, hipFuncAttributeMaxDynamicSharedMemorySize, LDS_BYTES) != hipSuccess) { fprintf(stderr, "kernel_launch: hipFuncSetAttribute failed\n"); grid = -1; return; }
        if (hipOccupancyMaxActiveBlocksPerMultiprocessor(&per_cu, (const void*)fwd_kernel, NWAVES * 64, LDS_BYTES) != hipSuccess || per_cu < 1)
            fprintf(stderr, "kernel_launch: note: occupancy query reports %d workgroups per CU\n", per_cu);
        (void)hipGetLastError();
        grid = cus;
        if (grid != 256) fprintf(stderr, "kernel_launch: warning: %d CUs (built for 256)\n", grid);
    }
    if (grid < 0) return;
    (void)hipMemsetAsync((char*)d_ws + WS_CTL, 0, CTL_ZERO_BYTES, stream);
    Args a{};
    for (int i = 0; i < 17; ++i) a.in[i] = (const float*)d_in[i];
    a.out = (float*)d_out; a.ws = (unsigned char*)d_ws;
    if (MK_N_LAUNCHES == 1) {
#if defined(PROBE_PREFIX)
        a.ph_lo = 0; a.ph_hi = PROBE_PREFIX; a.li = 0;
        hipLaunchKernelGGL(fwd_kernel, dim3(grid), dim3(NWAVES * 64), LDS_BYTES, stream, a);
        (void)hipMemsetAsync((char*)d_ws + WS_CTL, 0, CTL_ZERO_BYTES, stream);
#endif
        a.ph_lo = 0; a.ph_hi = N_PHASES; a.li = 0;
        hipLaunchKernelGGL(fwd_kernel, dim3(grid), dim3(NWAVES * 64), LDS_BYTES, stream, a);
    } else {
        for (int p = 0; p < N_PHASES; ++p) { a.ph_lo = p; a.ph_hi = p + 1; a.li = p; hipLaunchKernelGGL(fwd_kernel, dim3(grid), dim3(NWAVES * 64), LDS_BYTES, stream, a); }
    }
}
```

```cpp
#include <hip/hip_runtime.h>
#include <cstdio>
#include <cstdint>

#ifndef REPEAT_MASK
#define REPEAT_MASK 0
#endif
#define TWICE(k, ...) do { { __VA_ARGS__ } if ((REPEAT_MASK >> (k)) & 1) { __VA_ARGS__ } } while (0)
#ifndef FP8_SCALE_ARG
#define FP8_SCALE_ARG 0x7F7F7F7F
#endif
#ifndef EPI_ALIGN_OUT
#define EPI_ALIGN_OUT true
#endif
#ifndef MK_N_LAUNCHES
#define MK_N_LAUNCHES 1
#endif

constexpr int BATCH = 4, SEQ = 8192, D = 1024, T = BATCH * SEQ;
constexpr int NPROJ = 6656;
constexpr int PROJ_LD = 5888;
constexpr float U_SCALE = 8.0f;
constexpr int PC_Q0 = 0, PC_BG = 256, PC_Q1 = 1024, PC_Q2 = 1280, PC_K = 1536, PC_V = 2304, PC_U = 3072, PC_G = 3840;
constexpr int PC_O = 0, PC_C = 256, PC_M = 1024;
constexpr int WAC_LDB = 1024;
constexpr int NEXP = 32, FF = 512, CAP = T;
constexpr int MAXSLOT = 73728;
constexpr float RMS_EPS = 1e-6f;
constexpr float LOG2E = 1.4426950408889634f;
constexpr float W13_SCALE = 64.0f, W2_SCALE = 32.0f, WQ_SCALE = 256.0f, WKV_SCALE = 32.0f, Y_SCALE = 16.0f;
constexpr float QSCALE = 0.125f * LOG2E;
constexpr float WC8_CLIP = 4.0f * 0.03608439f;
constexpr float WA8_CLIP = 4.0f * 0.0625f;
constexpr float MERGED_CLIP = 3.0f;
constexpr float W8_CLIP = 4.0f * 0.03125f;

constexpr size_t MiB = 1u << 20;
constexpr size_t WS_CTL = 0, CTL_ZERO_BYTES = 128 * 1024;
constexpr size_t WS_RL = 1 * MiB;
constexpr size_t WS_TOKINFO = 1 * MiB;
constexpr size_t WS_IRS1 = 1 * MiB + 768 * 1024;
constexpr size_t WS_WRT = 1 * MiB + 512 * 1024;
constexpr size_t WS_WAC = 2 * MiB;
constexpr size_t WS_WO = 4 * MiB;
constexpr size_t WS_LIST = 6 * MiB;
constexpr size_t WS_WL = 10 * MiB;
constexpr size_t WS_RSL = 14 * MiB;
constexpr size_t WS_WIN = 18 * MiB;
constexpr size_t WS_X1B = 32 * MiB;
constexpr size_t WS_PROJ = 96 * MiB;
constexpr size_t WS_W13 = WS_PROJ;
constexpr size_t WS_W2 = WS_PROJ + 64 * MiB;
constexpr size_t WS_HID = WS_PROJ + 96 * MiB;
constexpr size_t WS_Y = WS_PROJ + 168 * MiB;
constexpr size_t WS_X1Q = 464 * MiB;
constexpr size_t WS_WINQ = 496 * MiB;
constexpr size_t WS_END = 501 * MiB;
static_assert(WS_PROJ + (size_t)T * PROJ_LD * 2 <= WS_END && WS_Y + (size_t)MAXSLOT * 1024 * 2 <= WS_END, "d_ws map");
constexpr int CW_TMO = 0;
constexpr int CW_BAR = 4096;
constexpr int CW_CNT = 16384;

constexpr int RING_BYTES = 131072;
constexpr int L_MISC = RING_BYTES;
constexpr int L_HIST = L_MISC + 512;
constexpr int L_LBASE = L_HIST + 128;
constexpr int L_CNT = L_LBASE + 128;
constexpr int L_TPRE = L_CNT + 128;
constexpr int L_NU = L_TPRE + 256;
constexpr int L_UTAB = L_NU + 128;
constexpr int L_GTAB = L_UTAB + 256;
constexpr int L_REC = L_GTAB + 6 * 1024;
constexpr int LDS_ZERO_END = L_LBASE;
constexpr int LDS_BYTES = 147456;
static_assert(L_REC + 128 * 32 <= LDS_BYTES, "LDS map");
constexpr int MAXU = 6;

#define GAS __attribute__((address_space(1)))
#define LAS __attribute__((address_space(3)))
typedef unsigned short bf16;
typedef unsigned v4u __attribute__((ext_vector_type(4)));
typedef unsigned v2u __attribute__((ext_vector_type(2)));
typedef int v4i __attribute__((ext_vector_type(4)));
typedef float f32x4 __attribute__((ext_vector_type(4)));
typedef GAS unsigned gu32;
#define RLX_AGENT __ATOMIC_RELAXED, __HIP_MEMORY_SCOPE_AGENT
#define LDS_WAIT() asm volatile("s_waitcnt lgkmcnt(0)" ::: "memory")
#define VM_WAIT() asm volatile("s_waitcnt vmcnt(0)" ::: "memory")
__device__ __forceinline__ unsigned f2bf(float f) { unsigned u = __builtin_bit_cast(unsigned, f); return (u + 0x7fffu + ((u >> 16) & 1u)) >> 16; }
__device__ __forceinline__ unsigned pk2(float lo, float hi) { return f2bf(lo) | (f2bf(hi) << 16); }
__device__ __forceinline__ float bflo(unsigned w) { return __builtin_bit_cast(float, w << 16); }
__device__ __forceinline__ float bfhi(unsigned w) { return __builtin_bit_cast(float, w & 0xffff0000u); }
__device__ __forceinline__ float fast_exp2(float x) { return __builtin_amdgcn_exp2f(x); }
__device__ __forceinline__ float fast_rcp(float x) { return __builtin_amdgcn_rcpf(x); }
__device__ __forceinline__ float sigmoidf_(float z) { return fast_rcp(1.0f + fast_exp2(-z * LOG2E)); }

__device__ __forceinline__ unsigned pack4_i8_biased(float a, float b, float c, float d) {
    unsigned t = 0u;
    t = __builtin_amdgcn_cvt_pk_u8_f32(__builtin_rintf(a), 0, t); t = __builtin_amdgcn_cvt_pk_u8_f32(__builtin_rintf(b), 1, t); t = __builtin_amdgcn_cvt_pk_u8_f32(__builtin_rintf(c), 2, t); t = __builtin_amdgcn_cvt_pk_u8_f32(__builtin_rintf(d), 3, t);
    return t ^ 0x80808080u;
}
__device__ __forceinline__ unsigned pack4_i8(float a, float b, float c, float d) {
    const int q0 = (int)__builtin_rintf(fminf(fmaxf(a, -127.f), 127.f)), q1 = (int)__builtin_rintf(fminf(fmaxf(b, -127.f), 127.f)), q2 = (int)__builtin_rintf(fminf(fmaxf(c, -127.f), 127.f)), q3 = (int)__builtin_rintf(fminf(fmaxf(d, -127.f), 127.f));
    return (unsigned)(q0 & 255) | ((unsigned)(q1 & 255) << 8) | ((unsigned)(q2 & 255) << 16) | ((unsigned)q3 << 24);
}

namespace pg8 {
#define PG8_LAS __attribute__((address_space(3)))
typedef unsigned short bf16_t;
typedef short bf16x8 __attribute__((ext_vector_type(8)));
typedef float f32x4 __attribute__((ext_vector_type(4)));
typedef unsigned u32x4 __attribute__((ext_vector_type(4)));
typedef unsigned u32x2 __attribute__((ext_vector_type(2)));
constexpr int BM = 256, BK = 64, HALF = 128, HTB = HALF * BK * 2, STAGE_BYTES = 8 * HTB, NXCD = 8, WGM = 8;

__host__ __device__ __forceinline__ int lds_byte(int r, int c) { const int st = (r >> 4) * 2 + (c >> 5), rr = r & 15, cc = c & 31, ob = rr * 64 + cc * 2; return st * 1024 + (ob ^ (((ob >> 9) & 1) << 5)); }
__host__ __device__ __forceinline__ void stage_rc(int b, int& R, int& C) { const int st = b / 1024, sb = b % 1024, swz = sb ^ (((sb >> 9) & 1) << 5); R = (st >> 1) * 16 + swz / 64; C = (st & 1) * 32 + (swz % 64) / 2; }
__host__ __device__ __forceinline__ int perm32(int rho) { const int n = rho >> 4, i = rho & 15; return 8 * (i >> 2) + 4 * n + (i & 3); }

struct Unit { int pm, pn, e, pos0, rows; };
struct Gemm { const bf16_t* A; const bf16_t* Bt; int K, lda, ldb; };

struct StaticOrder {
    int nM, nN, nwg, G, c;
    __device__ void init(int M, int N, int G_, int c_) { nM = M / BM; nN = N / BM; nwg = nM * nN; G = G_; c = c_; }
    __device__ bool next(int i, Unit& u) const {
        const long L = (long)i * G + c; if (L >= nwg) return false;
        int wgid = (int)L; { const int q = nwg / NXCD, r = nwg % NXCD, xcd = wgid % NXCD, off = wgid / NXCD; wgid = (xcd < r ? xcd * (q + 1) : r * (q + 1) + (xcd - r) * q) + off; }
        const int nig = WGM * nN, gid = wgid / nig, fm = gid * WGM, gsz = (nM - fm) < WGM ? (nM - fm) : WGM;
        u.pm = fm + ((wgid % nig) % gsz); u.pn = (wgid % nig) / gsz; u.e = 0; u.pos0 = 0; u.rows = BM; return true;
    }
    __device__ __forceinline__ int gather_tok(int, int) const { return 0; }
};
template <bool QKV> struct MapOrder : StaticOrder {
    __device__ bool next(int i, Unit& u) const {
        if (!StaticOrder::next(i, u)) return false;
        if (QKV) { u.e = u.pn == 0 ? 0 : (u.pn < 9 ? u.pn + 3 : u.pn + 9); }
        else { u.pn = u.pn < 3 ? u.pn + 1 : u.pn + 9; u.e = u.pn; }
        return true;
    }
};
struct MoeOrder {
    const PG8_LAS int* utab; const PG8_LAS int* gtab; int n;
    __device__ __forceinline__ bool next(int i, Unit& u) const {
        if (i >= n) return false;
        u.pm = __builtin_amdgcn_readfirstlane(utab[i * 8 + 0]); u.pn = __builtin_amdgcn_readfirstlane(utab[i * 8 + 1]); u.e = __builtin_amdgcn_readfirstlane(utab[i * 8 + 2]);
        u.pos0 = __builtin_amdgcn_readfirstlane(utab[i * 8 + 3]); u.rows = __builtin_amdgcn_readfirstlane(utab[i * 8 + 4]); return true;
    }
    __device__ __forceinline__ int gather_tok(int ui, int r) const { return gtab[ui * 256 + r]; }
};

typedef float f32x2_t __attribute__((ext_vector_type(2))); typedef __bf16 bf16x2_t __attribute__((ext_vector_type(2)));
__device__ __forceinline__ unsigned cvt_pk_bf16(float lo, float hi) { const f32x2_t v = {lo, hi}; const bf16x2_t b = __builtin_convertvector(v, bf16x2_t); return __builtin_bit_cast(unsigned, b); }
__device__ __forceinline__ u32x4 pack8(const f32x4 v0, const f32x4 v1) { u32x4 w; w.x = cvt_pk_bf16(v0[0], v0[1]); w.y = cvt_pk_bf16(v0[2], v0[3]); w.z = cvt_pk_bf16(v1[0], v1[1]); w.w = cvt_pk_bf16(v1[2], v1[3]); return w; }

typedef int i32x8 __attribute__((ext_vector_type(8))); typedef int i32x4 __attribute__((ext_vector_type(4)));
__device__ __forceinline__ i32x8 cat8(const bf16x8 a, const bf16x8 b) { const i32x4 x = __builtin_bit_cast(i32x4, a), y = __builtin_bit_cast(i32x4, b); return __builtin_shufflevector(x, y, 0, 1, 2, 3, 4, 5, 6, 7); }
__device__ __forceinline__ void mfma_fp8_inplace(f32x4& acc, const i32x8 a, const i32x8 b) {
    asm volatile("v_mfma_f32_16x16x128_f8f6f4 %0, %1, %2, %0" : "+v"(acc) : "v"(a), "v"(b));
}
__device__ __forceinline__ u32x2 pack8_fp8(const f32x4 v0, const f32x4 v1) { u32x2 w; int t = 0; t = __builtin_amdgcn_cvt_pk_fp8_f32(v0[0], v0[1], t, false); t = __builtin_amdgcn_cvt_pk_fp8_f32(v0[2], v0[3], t, true); w.x = (unsigned)t;
    t = 0; t = __builtin_amdgcn_cvt_pk_fp8_f32(v1[0], v1[1], t, false); t = __builtin_amdgcn_cvt_pk_fp8_f32(v1[2], v1[3], t, true); w.y = (unsigned)t; return w; }
__device__ __forceinline__ void store2x8(unsigned char* pa, unsigned char* pb, const u32x2 A, const u32x2 B, int fq) {
    const auto rx = __builtin_amdgcn_permlane16_swap(A.x, B.x, false, false), ry = __builtin_amdgcn_permlane16_swap(A.y, B.y, false, false);
    unsigned char* p = (fq & 1) ? pb - 8 : pa;
    *(u32x4*)p = (u32x4){rx[0], ry[0], rx[1], ry[1]};
}
__device__ __forceinline__ void load2x8(const unsigned char* pa, const unsigned char* pb, u32x2& A, u32x2& B, int fq) {
    const u32x4 w = *(const u32x4*)((fq & 1) ? pb - 8 : pa);
    const auto rx = __builtin_amdgcn_permlane16_swap(w.x, w.z, false, false), ry = __builtin_amdgcn_permlane16_swap(w.y, w.w, false, false);
    A.x = rx[0]; A.y = ry[0]; B.x = rx[1]; B.y = ry[1];
}
template <class Epi, class Sched, bool ALIGN_EPI, bool GATHER, int QM = 0, int MIXT = 0>
__device__ __forceinline__ void gemm_phase(PG8_LAS unsigned char* lds, const Gemm g, const Sched& S, const Epi& E) {
    const int tid = threadIdx.x, wid = __builtin_amdgcn_readfirstlane(tid >> 6), lane = tid & 63, wr = wid >> 2, wc = wid & 3, fr = lane & 15, fq = lane >> 4;
    const int K = g.K, nt = K / BK;
    const unsigned ldaB = (unsigned)g.lda * 2u, ldbB = (unsigned)g.ldb * 2u;
    int RA[2]; unsigned cA2[2], vB0[2], vB1[2];
#pragma unroll
    for (int i = 0; i < 2; ++i) { int R, C; stage_rc(tid * 16 + i * 8192, R, C); const int Rb = Epi::PERM ? ((R & ~31) + perm32(R & 31)) : R;
        RA[i] = R; cA2[i] = (unsigned)C * 2u; vB0[i] = (unsigned)Rb * ldbB + (unsigned)C * 2u; vB1[i] = vB0[i] + (unsigned)HALF * ldbB; }
    const size_t kstep = (size_t)(BK * 2);
    const size_t tstepA = (size_t)BM * ldaB, tstepB = (size_t)BM * ldbB;
    const unsigned ldsw = (unsigned)wid * 1024u;
    constexpr bool FP8 = (QM == 1);
    const int aoff = lds_byte(wr * 64 + fr, fq * 8), boff = lds_byte(wc * 32 + fr, fq * 8);
    constexpr int KSTR = 1024;
#define PG8_SA(b, h) (((b) * 2 + (h)) * HTB)
#define PG8_SB(b, h) ((4 + (b) * 2 + (h)) * HTB)
#define PG8_STAGE(bufoff, gbase, voff) do { _Pragma("unroll") for (int _i = 0; _i < 2; ++_i) \
        __builtin_amdgcn_global_load_lds((const unsigned*)((const char*)(gbase) + (voff)[_i]), (PG8_LAS unsigned*)(lds + (bufoff) + ldsw + _i * 8192), 16, 0, 0); } while (0)
#define PG8_LDA(dst, b, h) do { _Pragma("unroll") for (int m = 0; m < 4; ++m) _Pragma("unroll") for (int k = 0; k < 2; ++k) dst[m][k] = *(const PG8_LAS bf16x8*)(lds + PG8_SA(b, h) + aoff + m * 2048 + k * KSTR); } while (0)
#define PG8_LDB(dst, b, h) do { _Pragma("unroll") for (int n = 0; n < 2; ++n) _Pragma("unroll") for (int k = 0; k < 2; ++k) dst[n][k] = *(const PG8_LAS bf16x8*)(lds + PG8_SB(b, h) + boff + n * 2048 + k * KSTR); } while (0)
#define PG8_MMA(ai, bj, At, Bt) do { __builtin_amdgcn_s_setprio(1); _Pragma("unroll") for (int m = 0; m < 4; ++m) _Pragma("unroll") for (int n = 0; n < 2; ++n) { \
        if constexpr (FP8) { mfma_fp8_inplace(acc[ai][bj][m][n], cat8(Bt[n][0], Bt[n][1]), cat8(At[m][0], At[m][1])); } \
        else if constexpr (QM == 2) { _Pragma("unroll") for (int k = 0; k < 2; ++k) acc[ai][bj][m][n] = __builtin_bit_cast(f32x4, __builtin_amdgcn_mfma_i32_16x16x64_i8(__builtin_bit_cast(i32x4, Bt[n][k]), __builtin_bit_cast(i32x4, At[m][k]), __builtin_bit_cast(i32x4, acc[ai][bj][m][n]), 0, 0, 0)); } \
        else { _Pragma("unroll") for (int k = 0; k < 2; ++k) acc[ai][bj][m][n] = __builtin_amdgcn_mfma_f32_16x16x32_bf16(Bt[n][k], At[m][k], acc[ai][bj][m][n], 0, 0, 0); } } \
        __builtin_amdgcn_s_setprio(0); } while (0)
#define PG8_MMA_I8(ai, bj, At, Bt) do { __builtin_amdgcn_s_setprio(1); _Pragma("unroll") for (int m = 0; m < 4; ++m) _Pragma("unroll") for (int n = 0; n < 2; ++n) { \
        _Pragma("unroll") for (int k = 0; k < 2; ++k) acc[ai][bj][m][n] = __builtin_bit_cast(f32x4, __builtin_amdgcn_mfma_i32_16x16x64_i8(__builtin_bit_cast(i32x4, Bt[n][k]), __builtin_bit_cast(i32x4, At[m][k]), __builtin_bit_cast(i32x4, acc[ai][bj][m][n]), 0, 0, 0)); } \
        __builtin_amdgcn_s_setprio(0); } while (0)
#define PG8_WAIT_V(n) asm volatile("s_waitcnt vmcnt(" #n ")" ::: "memory")
#define PG8_WAIT_L(n) asm volatile("s_waitcnt lgkmcnt(" #n ")" ::: "memory")
#define PG8_BAR __builtin_amdgcn_s_barrier()
#define PG8_SCHED __builtin_amdgcn_sched_barrier(0)
#define PG8_SETA(v, ui) do { _Pragma("unroll") for (int _i = 0; _i < 2; ++_i) { \
        if constexpr (GATHER) { (v)[0][_i] = (unsigned)S.gather_tok((ui), RA[_i]) * ldaB + cA2[_i]; (v)[1][_i] = (unsigned)S.gather_tok((ui), RA[_i] + HALF) * ldaB + cA2[_i]; } \
        else { (v)[0][_i] = (unsigned)RA[_i] * ldaB + cA2[_i]; (v)[1][_i] = (v)[0][_i] + (unsigned)HALF * ldaB; } } } while (0)
    Unit cur, nxt; int ui = 0;
    if (!S.next(0, cur)) return;
    f32x4 acc[2][2][4][2];
#pragma unroll
    for (int a = 0; a < 2; ++a)
#pragma unroll
        for (int b = 0; b < 2; ++b)
#pragma unroll
            for (int m = 0; m < 4; ++m)
#pragma unroll
                for (int n = 0; n < 2; ++n) acc[a][b][m][n] = (f32x4){0.f, 0.f, 0.f, 0.f};
    bf16x8 At[4][2], B0[2][2], B1[2][2];
    unsigned vA[2][2], nvA[2][2];
    PG8_SETA(vA, 0);
#pragma unroll
    for (int i = 0; i < 2; ++i) { nvA[0][i] = vA[0][i]; nvA[1][i] = vA[1][i]; }
    const char* cA = GATHER ? (const char*)g.A : (const char*)g.A + (size_t)cur.pm * tstepA; const char* cB = (const char*)g.Bt + (size_t)cur.pn * tstepB;
    PG8_STAGE(PG8_SB(0, 0), cB, vB0); PG8_STAGE(PG8_SB(0, 1), cB, vB1); PG8_STAGE(PG8_SA(0, 0), cA, vA[0]); PG8_STAGE(PG8_SA(0, 1), cA, vA[1]);
    if (wr == 1) PG8_BAR;
    PG8_WAIT_V(2); PG8_BAR;
    PG8_STAGE(PG8_SB(1, 0), cB + kstep, vB0); PG8_STAGE(PG8_SA(1, 0), cA + kstep, vA[0]); PG8_STAGE(PG8_SB(1, 1), cB + kstep, vB1);
    PG8_WAIT_V(6); PG8_BAR;
    for (;;) {
        const bool has_next = S.next(ui + 1, nxt);
        const char* nA = GATHER ? cA : (has_next ? (const char*)g.A + (size_t)nxt.pm * tstepA : cA);
        const char* nB = has_next ? (const char*)g.Bt + (size_t)nxt.pn * tstepB : cB;
        if constexpr (GATHER) { if (has_next) { PG8_SETA(nvA, ui + 1); } }
#define PG8_ITER(MM, t) do { \
            const bool last = ((t) == nt - 2); \
            const char* a1 = cA + (size_t)((t) + 1) * kstep; \
            const char* a2 = last ? nA : cA + (size_t)((t) + 2) * kstep; const char* b2 = last ? nB : cB + (size_t)((t) + 2) * kstep; \
            const char* a3 = a2 + kstep; const char* b3 = b2 + kstep; \
            unsigned w0[2], w1[2]; \
            _Pragma("unroll") for (int i = 0; i < 2; ++i) { if constexpr (GATHER) { w0[i] = last ? nvA[0][i] : vA[0][i]; w1[i] = last ? nvA[1][i] : vA[1][i]; } else { w0[i] = vA[0][i]; w1[i] = vA[1][i]; } } \
            PG8_LDB(B0, 0, 0); PG8_SCHED; PG8_LDA(At, 0, 0); PG8_SCHED; PG8_LDB(B1, 0, 1); PG8_SCHED; PG8_STAGE(PG8_SA(1, 1), a1, vA[1]); \
            PG8_WAIT_V(8); PG8_WAIT_L(4); PG8_BAR; MM(0, 0, At, B0); PG8_WAIT_L(0); MM(0, 1, At, B1); PG8_BAR; PG8_SCHED; \
            PG8_LDA(At, 0, 1); PG8_STAGE(PG8_SB(0, 0), b2, vB0); PG8_STAGE(PG8_SB(0, 1), b2, vB1); PG8_STAGE(PG8_SA(0, 0), a2, w0); \
            PG8_WAIT_V(8); PG8_WAIT_L(0); PG8_BAR; MM(1, 0, At, B0); MM(1, 1, At, B1); PG8_BAR; PG8_SCHED; \
            PG8_LDB(B0, 1, 0); PG8_SCHED; PG8_LDA(At, 1, 0); PG8_SCHED; PG8_LDB(B1, 1, 1); PG8_SCHED; PG8_STAGE(PG8_SA(0, 1), a2, w1); \
            PG8_WAIT_V(8); PG8_WAIT_L(4); PG8_BAR; MM(0, 0, At, B0); PG8_WAIT_L(0); MM(0, 1, At, B1); PG8_BAR; PG8_SCHED; \
            PG8_LDA(At, 1, 1); PG8_STAGE(PG8_SB(1, 0), b3, vB0); PG8_STAGE(PG8_SB(1, 1), b3, vB1); PG8_STAGE(PG8_SA(1, 0), a3, w0); \
            PG8_WAIT_V(8); PG8_WAIT_L(0); PG8_BAR; MM(1, 0, At, B0); MM(1, 1, At, B1); PG8_BAR; PG8_SCHED; } while (0)
        int t0 = 0;
        if constexpr (MIXT > 0) {
            static_assert(MIXT == 2 && Epi::HAS_MID && Epi::MID_T == 0, "mixed mode: one peeled int8 iteration followed by the hook");
            int tend = MIXT; asm volatile("" : "+s"(tend));
#pragma unroll 1
            for (int t = 0; t < tend; t += 2) {
                asm volatile("" : "+v"(vA[0][0]), "+v"(vA[0][1]), "+v"(vA[1][0]), "+v"(vA[1][1]), "+v"(vB0[0]), "+v"(vB0[1]), "+v"(vB1[0]), "+v"(vB1[1]));
                PG8_ITER(PG8_MMA_I8, t);
            }
            E.mid(acc, cur, wr, wc, fr, fq);
            t0 = MIXT;
        }
#pragma unroll 1
        for (int t = t0; t < nt; t += 2) {
            if constexpr (FP8 || MIXT > 0) asm volatile("" : "+v"(vA[0][0]), "+v"(vA[0][1]), "+v"(vA[1][0]), "+v"(vA[1][1]), "+v"(vB0[0]), "+v"(vB0[1]), "+v"(vB1[0]), "+v"(vB1[1]));
            PG8_ITER(PG8_MMA, t);
            if constexpr (Epi::HAS_MID && MIXT == 0) { if (t == Epi::MID_T) E.mid(acc, cur, wr, wc, fr, fq); }
        }
        if constexpr (FP8) asm volatile("s_nop 15\n\ts_nop 15" ::: "memory");
        if constexpr (ALIGN_EPI) { if (wr == 0) PG8_BAR; }
        E(acc, cur, wr, wc, fr, fq);
        if (!has_next) break;
#pragma unroll
        for (int a = 0; a < 2; ++a)
#pragma unroll
            for (int b = 0; b < 2; ++b)
#pragma unroll
                for (int m = 0; m < 4; ++m)
#pragma unroll
                    for (int n = 0; n < 2; ++n) acc[a][b][m][n] = (f32x4){0.f, 0.f, 0.f, 0.f};
        cur = nxt; cA = nA; cB = nB; ++ui;
        if constexpr (GATHER) {
#pragma unroll
            for (int i = 0; i < 2; ++i) { vA[0][i] = nvA[0][i]; vA[1][i] = nvA[1][i]; }
        }
        if constexpr (ALIGN_EPI) { if (wr == 1) PG8_BAR; }
    }
    PG8_WAIT_V(0);
    if constexpr (!ALIGN_EPI) { if (wr == 0) PG8_BAR; }
    PG8_BAR;
#undef PG8_SA
#undef PG8_SB
#undef PG8_STAGE
#undef PG8_LDA
#undef PG8_LDB
#undef PG8_MMA
#undef PG8_MMA_I8
#undef PG8_ITER
#undef PG8_WAIT_V
#undef PG8_WAIT_L
#undef PG8_BAR
#undef PG8_SCHED
#undef PG8_SETA
}

struct EpiProj {
    static constexpr bool PERM = true, HAS_MID = false; static constexpr int MID_T = -1;
    bf16_t* P; const float* bgate;
    __device__ __forceinline__ void mid(f32x4 (&)[2][2][4][2], const Unit&, int, int, int, int) const {}
    __device__ __forceinline__ void operator()(const f32x4 (&acc)[2][2][4][2], const Unit& u, int wr, int wc, int fr, int fq) const {
        asm volatile("" : "+v"(fr), "+v"(fq));
        const int row0 = u.pm * BM + wr * 64 + fr; const int pn = u.e;
        if (pn < 12) {
            const int col0 = pn * 256 + wc * 32 + 8 * fq;
#pragma unroll
            for (int ai = 0; ai < 2; ++ai)
#pragma unroll
                for (int m = 0; m < 4; ++m) { bf16_t* rowp = P + (size_t)(row0 + ai * HALF + m * 16) * PROJ_LD + col0;
#pragma unroll
                    for (int bj = 0; bj < 2; ++bj) *(u32x4*)(rowp + bj * HALF) = pack8(acc[ai][bj][m][0], acc[ai][bj][m][1]); }
        } else if (pn < 18) {
            const int col0 = PC_U + (pn - 12) * 128 + wc * 32 + 8 * fq;
#pragma unroll
            for (int ai = 0; ai < 2; ++ai)
#pragma unroll
                for (int m = 0; m < 4; ++m) { bf16_t* rowp = P + (size_t)(row0 + ai * HALF + m * 16) * PROJ_LD + col0;
                    *(u32x4*)rowp = pack8(acc[ai][0][m][0] * acc[ai][1][m][0], acc[ai][0][m][1] * acc[ai][1][m][1]); }
        } else {
            const int cg0 = (pn - 18) * 256 + wc * 32 + 8 * fq;
            f32x4 bv[2][2];
#pragma unroll
            for (int bj = 0; bj < 2; ++bj)
#pragma unroll
                for (int n = 0; n < 2; ++n) bv[bj][n] = *(const f32x4*)(bgate + cg0 + bj * HALF + 4 * n);
#pragma unroll
            for (int ai = 0; ai < 2; ++ai)
#pragma unroll
                for (int m = 0; m < 4; ++m) { bf16_t* rowp = P + (size_t)(row0 + ai * HALF + m * 16) * PROJ_LD + PC_G + cg0;
#pragma unroll
                    for (int bj = 0; bj < 2; ++bj) { f32x4 z0 = acc[ai][bj][m][0] + bv[bj][0], z1 = acc[ai][bj][m][1] + bv[bj][1];
#if !defined(DBG_NO_SIG)
#pragma unroll
                        for (int j = 0; j < 4; ++j) { z0[j] = sigmoidf_(z0[j]); z1[j] = sigmoidf_(z1[j]); }
#endif
                        *(u32x4*)(rowp + bj * HALF) = pack8(z0, z1); } }
        }
    }
};
struct EpiProjI8 {
    static constexpr bool PERM = true, HAS_MID = false; static constexpr int MID_T = -1;
    bf16_t* P; const float* bgate; const float* sx;
    __device__ __forceinline__ void mid(f32x4 (&)[2][2][4][2], const Unit&, int, int, int, int) const {}
    __device__ __forceinline__ f32x4 deq(const f32x4 a, float s) const { const i32x4 ai = __builtin_bit_cast(i32x4, a); return __builtin_convertvector(ai, f32x4) * s; }
    __device__ __forceinline__ void operator()(const f32x4 (&acc)[2][2][4][2], const Unit& u, int wr, int wc, int fr, int fq) const {
        asm volatile("" : "+v"(fr), "+v"(fq));
        const int row0 = u.pm * BM + wr * 64 + fr; const int pn = u.pn;
        const float sw = (pn == 0 || pn == 4 || pn == 5) ? (W8_CLIP * QSCALE / 127.0f) : (W8_CLIP / 127.0f);
        float sxv[2][4];
#pragma unroll
        for (int ai = 0; ai < 2; ++ai)
#pragma unroll
            for (int m = 0; m < 4; ++m) sxv[ai][m] = sx[row0 + ai * HALF + m * 16];
        asm volatile("" ::: "memory");
        if (pn >= 6 && pn < 12) {
            const int col0 = (pn - 6) * 256 + wc * 32 + 8 * fq;
#pragma unroll
            for (int ai = 0; ai < 2; ++ai)
#pragma unroll
                for (int mp = 0; mp < 4; mp += 2) { const int row = row0 + ai * HALF + mp * 16; const float sa = sxv[ai][mp] * sw, sb = sxv[ai][mp + 1] * sw;
                    unsigned char* pa = (unsigned char*)(P + (size_t)row * PROJ_LD + PC_K) + col0; unsigned char* pb = pa + (size_t)16 * PROJ_LD * 2;
#pragma unroll
                    for (int bj = 0; bj < 2; ++bj) store2x8(pa + bj * HALF, pb + bj * HALF, pack8_fp8(deq(acc[ai][bj][mp][0], sa), deq(acc[ai][bj][mp][1], sa)), pack8_fp8(deq(acc[ai][bj][mp + 1][0], sb), deq(acc[ai][bj][mp + 1][1], sb)), fq); }
        } else if (pn == 0 || pn == 4 || pn == 5) {
            const int col0 = wc * 32 + 8 * fq;
#pragma unroll
            for (int ai = 0; ai < 2; ++ai)
#pragma unroll
                for (int mp = 0; mp < 4; mp += 2) { const int row = row0 + ai * HALF + mp * 16; const float sa = sxv[ai][mp] * sw, sb = sxv[ai][mp + 1] * sw;
                    unsigned char* pa = (unsigned char*)(P + (size_t)row * PROJ_LD + pn * 256) + col0; unsigned char* pb = pa + (size_t)16 * PROJ_LD * 2;
#pragma unroll
                    for (int bj = 0; bj < 2; ++bj) store2x8(pa + bj * HALF, pb + bj * HALF, pack8_fp8(deq(acc[ai][bj][mp][0], sa), deq(acc[ai][bj][mp][1], sa)), pack8_fp8(deq(acc[ai][bj][mp + 1][0], sb), deq(acc[ai][bj][mp + 1][1], sb)), fq); }
        } else if (pn < 12) {
            const int col0 = pn * 256 + wc * 32 + 8 * fq;
#pragma unroll
            for (int ai = 0; ai < 2; ++ai)
#pragma unroll
                for (int m = 0; m < 4; ++m) { const int row = row0 + ai * HALF + m * 16; const float s_ = sxv[ai][m] * sw; bf16_t* rowp = P + (size_t)row * PROJ_LD + col0;
#pragma unroll
                    for (int bj = 0; bj < 2; ++bj) *(u32x4*)(rowp + bj * HALF) = pack8(deq(acc[ai][bj][m][0], s_), deq(acc[ai][bj][m][1], s_)); }
        } else if (pn < 18) {
            const int cb0 = (pn - 12) * 128 + wc * 32 + 8 * fq;
#pragma unroll
            for (int ai = 0; ai < 2; ++ai)
#pragma unroll
                for (int mp = 0; mp < 4; mp += 2) { const int row = row0 + ai * HALF + mp * 16; const float sa = sxv[ai][mp] * sw, sb = sxv[ai][mp + 1] * sw;
                    unsigned char* pa = (unsigned char*)(P + (size_t)row * PROJ_LD + PC_U) + cb0; unsigned char* pb = pa + (size_t)16 * PROJ_LD * 2;
                    store2x8(pa, pb, pack8_fp8(deq(acc[ai][0][mp][0], sa) * deq(acc[ai][1][mp][0], sa) * U_SCALE, deq(acc[ai][0][mp][1], sa) * deq(acc[ai][1][mp][1], sa) * U_SCALE),
                                     pack8_fp8(deq(acc[ai][0][mp + 1][0], sb) * deq(acc[ai][1][mp + 1][0], sb) * U_SCALE, deq(acc[ai][0][mp + 1][1], sb) * deq(acc[ai][1][mp + 1][1], sb) * U_SCALE), fq); }
        } else {
            const int cg0 = (pn - 18) * 256 + wc * 32 + 8 * fq;
            const float glo = pn >= 22 ? 1.0f : 0.0f;
            f32x4 bv[2][2];
#pragma unroll
            for (int bj = 0; bj < 2; ++bj)
#pragma unroll
                for (int n = 0; n < 2; ++n) bv[bj][n] = *(const f32x4*)(bgate + cg0 + bj * HALF + 4 * n) * (-LOG2E);
#pragma unroll
            for (int ai = 0; ai < 2; ++ai)
#pragma unroll
                for (int mp = 0; mp < 4; mp += 2) { const int row = row0 + ai * HALF + mp * 16; unsigned char* pa = (unsigned char*)(P + (size_t)row * PROJ_LD + PC_G) + cg0; unsigned char* pb = pa + (size_t)16 * PROJ_LD * 2;
#pragma unroll
                    for (int bj = 0; bj < 2; ++bj) { u32x2 w8[2];
#pragma unroll
                        for (int h = 0; h < 2; ++h) { const float s_ = sxv[ai][mp + h] * sw * (-LOG2E);
                            const f32x4 z0 = deq(acc[ai][bj][mp + h][0], s_) + bv[bj][0], z1 = deq(acc[ai][bj][mp + h][1], s_) + bv[bj][1];
                            unsigned t0 = 0u, t1 = 0u;
#pragma unroll
                            for (int j = 0; j < 4; ++j) {
                                t0 = __builtin_amdgcn_cvt_pk_u8_f32(fmaxf(__builtin_rintf(fast_rcp(fast_exp2(z0[j]) * (1.0f / 255.0f) + (1.0f / 255.0f))), glo), j, t0);
                                t1 = __builtin_amdgcn_cvt_pk_u8_f32(fmaxf(__builtin_rintf(fast_rcp(fast_exp2(z1[j]) * (1.0f / 255.0f) + (1.0f / 255.0f))), glo), j, t1); }
                            w8[h].x = t0; w8[h].y = t1; }
                        store2x8(pa + bj * HALF, pb + bj * HALF, w8[0], w8[1], fq); } }
        }
    }
};
struct EpiProjQ {
    static constexpr bool PERM = true, HAS_MID = false; static constexpr int MID_T = -1;
    bf16_t* P; const float* bgate;
    __device__ __forceinline__ void mid(f32x4 (&)[2][2][4][2], const Unit&, int, int, int, int) const {}
    __device__ __forceinline__ void operator()(const f32x4 (&acc)[2][2][4][2], const Unit& u, int wr, int wc, int fr, int fq) const {
        asm volatile("" : "+v"(fr), "+v"(fq));
        const int row0 = u.pm * BM + wr * 64 + fr; const int pn = u.e; const float sc = (pn == 0 || pn == 4 || pn == 5) ? (1.0f / WQ_SCALE) : (1.0f / WKV_SCALE);
        if (pn >= 18) {
            const int cg0 = (pn - 18) * 256 + wc * 32 + 8 * fq;
            f32x4 bv[2][2];
#pragma unroll
            for (int bj = 0; bj < 2; ++bj)
#pragma unroll
                for (int n = 0; n < 2; ++n) bv[bj][n] = *(const f32x4*)(bgate + cg0 + bj * HALF + 4 * n);
#pragma unroll
            for (int ai = 0; ai < 2; ++ai)
#pragma unroll
                for (int m = 0; m < 4; ++m) { bf16_t* rowp = P + (size_t)(row0 + ai * HALF + m * 16) * PROJ_LD + PC_G + cg0;
#pragma unroll
                    for (int bj = 0; bj < 2; ++bj) { f32x4 z0 = acc[ai][bj][m][0] * sc + bv[bj][0], z1 = acc[ai][bj][m][1] * sc + bv[bj][1];
#pragma unroll
                        for (int j = 0; j < 4; ++j) { z0[j] = sigmoidf_(z0[j]); z1[j] = sigmoidf_(z1[j]); }
                        *(u32x4*)(rowp + bj * HALF) = pack8(z0, z1); } }
            return;
        }
        const int col0 = pn * 256 + wc * 32 + 8 * fq;
#pragma unroll
        for (int ai = 0; ai < 2; ++ai)
#pragma unroll
            for (int m = 0; m < 4; ++m) { bf16_t* rowp = P + (size_t)(row0 + ai * HALF + m * 16) * PROJ_LD + col0;
#pragma unroll
                for (int bj = 0; bj < 2; ++bj) *(u32x4*)(rowp + bj * HALF) = pack8(acc[ai][bj][m][0] * sc, acc[ai][bj][m][1] * sc); }
    }
};
struct EpiMerged {
#if defined(DBG_NO_HOOK)
    static constexpr bool PERM = true, HAS_MID = false; static constexpr int MID_T = 2;
#else
    static constexpr bool PERM = true, HAS_MID = true; static constexpr int MID_T = 0;
#endif
    bf16_t* P; const float* sM; const float* sO; const float* sC;
    static __device__ __forceinline__ float ub(unsigned w, int i) { return (float)((w >> (8 * i)) & 0xffu); }
    __device__ __forceinline__ void mid(f32x4 (&acc)[2][2][4][2], const Unit& u, int wr, int wc, int fr, int fq) const {
        asm volatile("" : "+v"(fr), "+v"(fq));
        int row0 = u.pm * BM + wr * 64 + fr; int col0 = u.pn * 256 + wc * 32 + 8 * fq;
        asm volatile("" : "+v"(row0), "+v"(col0));
#pragma unroll
        for (int ai = 0; ai < 2; ++ai) {
            u32x2 ga[4][2], gb[4][2]; float so[4];
#pragma unroll
            for (int m = 0; m < 4; ++m) { const int row = row0 + ai * HALF + m * 16;
                so[m] = (sO[row] * WA8_CLIP) * fast_rcp(sC[row] * WC8_CLIP); }
#pragma unroll
            for (int mp = 0; mp < 4; mp += 2) { const unsigned char* pa = (const unsigned char*)(P + (size_t)(row0 + ai * HALF + mp * 16) * PROJ_LD + PC_G) + col0; const unsigned char* pb = pa + (size_t)16 * PROJ_LD * 2;
#pragma unroll
                for (int bj = 0; bj < 2; ++bj) { load2x8(pa + bj * HALF, pb + bj * HALF, ga[mp][bj], ga[mp + 1][bj], fq); load2x8(pa + 1024 + bj * HALF, pb + 1024 + bj * HALF, gb[mp][bj], gb[mp + 1][bj], fq); } }
#pragma unroll
            for (int m = 0; m < 4; ++m)
#pragma unroll
                for (int bj = 0; bj < 2; ++bj)
#pragma unroll
                    for (int n = 0; n < 2; ++n) { const f32x4 f = __builtin_convertvector(__builtin_bit_cast(i32x4, acc[ai][bj][m][n]), f32x4) * so[m]; f32x4 o;
#pragma unroll
                        for (int i = 0; i < 4; ++i) o[i] = f[i] * (ub(ga[m][bj][n], i) * fast_rcp(ub(gb[m][bj][n], i)));
                        acc[ai][bj][m][n] = __builtin_bit_cast(f32x4, __builtin_convertvector(o, i32x4)); }
            asm volatile("" ::: "memory"); }
    }
    __device__ __forceinline__ void operator()(const f32x4 (&acc)[2][2][4][2], const Unit& u, int wr, int wc, int fr, int fq) const {
        asm volatile("" : "+v"(fr), "+v"(fq));
        int row0 = u.pm * BM + wr * 64 + fr; int col0 = u.pn * 256 + wc * 32 + 8 * fq;
        asm volatile("" : "+v"(row0), "+v"(col0));
#pragma unroll
        for (int ai = 0; ai < 2; ++ai) {
            u32x2 gb[4][2]; float iq[4], sc_[4];
#pragma unroll
            for (int m = 0; m < 4; ++m) { const int row = row0 + ai * HALF + m * 16; iq[m] = sM[row]; sc_[m] = sC[row] * (WC8_CLIP / (127.0f * 255.0f)); }
#pragma unroll
            for (int mp = 0; mp < 4; mp += 2) { const unsigned char* pa = (const unsigned char*)(P + (size_t)(row0 + ai * HALF + mp * 16) * PROJ_LD + PC_G) + 1024 + col0; const unsigned char* pb = pa + (size_t)16 * PROJ_LD * 2;
#pragma unroll
                for (int bj = 0; bj < 2; ++bj) load2x8(pa + bj * HALF, pb + bj * HALF, gb[mp][bj], gb[mp + 1][bj], fq); }
#pragma unroll
            for (int mp = 0; mp < 4; mp += 2) { unsigned char* pa = (unsigned char*)(P + (size_t)(row0 + ai * HALF + mp * 16) * PROJ_LD) + 2048 + col0; unsigned char* pb = pa + (size_t)16 * PROJ_LD * 2;
#pragma unroll
                for (int bj = 0; bj < 2; ++bj) { u32x2 w8[2];
#pragma unroll
                    for (int h = 0; h < 2; ++h) { const int m = mp + h; const float q_ = sc_[m] / iq[m]; const u32x2 b = gb[m][bj];
                        const f32x4 f0 = __builtin_convertvector(__builtin_bit_cast(i32x4, acc[ai][bj][m][0]), f32x4), f1 = __builtin_convertvector(__builtin_bit_cast(i32x4, acc[ai][bj][m][1]), f32x4);
                        f32x4 v0, v1;
#pragma unroll
                        for (int i = 0; i < 4; ++i) { v0[i] = (f0[i] * ub(b.x, i)) * q_ + 128.0f; v1[i] = (f1[i] * ub(b.y, i)) * q_ + 128.0f; }
                        w8[h].x = pack4_i8_biased(v0[0], v0[1], v0[2], v0[3]); w8[h].y = pack4_i8_biased(v1[0], v1[1], v1[2], v1[3]); }
                    store2x8(pa + bj * HALF, pb + bj * HALF, w8[0], w8[1], fq); } }
            asm volatile("" ::: "memory"); }
    }
};
struct EpiOut {
    static constexpr bool PERM = true, HAS_MID = false; static constexpr int MID_T = -1;
    const float* x; bf16_t* x1b; unsigned char* x1q; const float* sM;
    __device__ __forceinline__ void mid(f32x4 (&)[2][2][4][2], const Unit&, int, int, int, int) const {}
    __device__ __forceinline__ void operator()(const f32x4 (&acc)[2][2][4][2], const Unit& u, int wr, int wc, int fr, int fq) const {
        asm volatile("" : "+v"(fr), "+v"(fq));
        const int row0 = u.pm * BM + wr * 64 + fr; const int col0 = u.pn * 256 + wc * 32 + 8 * fq;
#pragma unroll
        for (int ai = 0; ai < 2; ++ai) {
            f32x4 xv[4][2][2]; float sc[4];
#pragma unroll
            for (int m = 0; m < 4; ++m) { const size_t off = (size_t)(row0 + ai * HALF + m * 16) * D + col0; sc[m] = sM[row0 + ai * HALF + m * 16] * (W8_CLIP / 127.0f);
#pragma unroll
                for (int bj = 0; bj < 2; ++bj) { xv[m][bj][0] = *(const f32x4*)(x + off + bj * HALF); xv[m][bj][1] = *(const f32x4*)(x + off + bj * HALF + 4); } }
            asm volatile("" ::: "memory");
#pragma unroll
            for (int mp = 0; mp < 4; mp += 2) { const size_t off = (size_t)(row0 + ai * HALF + mp * 16) * D + col0;
#pragma unroll
                for (int bj = 0; bj < 2; ++bj) { u32x2 q8[2];
#pragma unroll
                    for (int h = 0; h < 2; ++h) { const int m = mp + h;
                        const f32x4 o0 = xv[m][bj][0] + __builtin_convertvector(__builtin_bit_cast(i32x4, acc[ai][bj][m][0]), f32x4) * sc[m], o1 = xv[m][bj][1] + __builtin_convertvector(__builtin_bit_cast(i32x4, acc[ai][bj][m][1]), f32x4) * sc[m];
                        *(u32x4*)(x1b + off + (size_t)h * 16 * D + bj * HALF) = pack8(o0, o1); q8[h] = pack8_fp8(o0, o1); }
                    store2x8(x1q + off + bj * HALF, x1q + off + (size_t)16 * D + bj * HALF, q8[0], q8[1], fq); } }
            asm volatile("" ::: "memory"); }
    }
};
struct EpiHid {
    static constexpr bool PERM = true, HAS_MID = false; static constexpr int MID_T = -1;
    unsigned char* H; const float* rsl;
    __device__ __forceinline__ void mid(f32x4 (&)[2][2][4][2], const Unit&, int, int, int, int) const {}
    __device__ __forceinline__ void operator()(const f32x4 (&acc)[2][2][4][2], const Unit& u, int wr, int wc, int fr, int fq) const {
        asm volatile("" : "+v"(fr), "+v"(fq));
        const int rl0 = wr * 64 + fr; const int col0 = (u.pn & 3) * 128 + wc * 32 + 8 * fq;
        float rsv[2][4];
#pragma unroll
        for (int ai = 0; ai < 2; ++ai)
#pragma unroll
            for (int m = 0; m < 4; ++m) { const int rl = rl0 + ai * HALF + m * 16; rsv[ai][m] = rl < u.rows ? rsl[(size_t)u.e * CAP + u.pos0 + rl] * (1.0f / W13_SCALE) : 0.f; }
        asm volatile("" ::: "memory");
#pragma unroll
        for (int ai = 0; ai < 2; ++ai)
#pragma unroll
            for (int mp = 0; mp < 4; mp += 2) { const int rl = rl0 + ai * HALF + mp * 16; u32x2 h8[2];
#pragma unroll
                for (int h = 0; h < 2; ++h) { const int m = mp + h; const float rs = rsv[ai][m];
                    const float rsn = -rs * LOG2E, k_ = fast_rcp(rs * rs);
                    f32x4 h0, h1;
#pragma unroll
                    for (int j = 0; j < 4; ++j) { const float A0 = acc[ai][0][m][0][j], B0 = acc[ai][1][m][0][j], A1 = acc[ai][0][m][1][j], B1 = acc[ai][1][m][1][j];
                        h0[j] = (A0 * B0) * fast_rcp(fast_exp2(A0 * rsn) * k_ + k_); h1[j] = (A1 * B1) * fast_rcp(fast_exp2(A1 * rsn) * k_ + k_); }
                    h8[h] = pack8_fp8(h0, h1); }
                unsigned char* pa = H + (size_t)(u.pm * BM + rl) * FF + col0;
                store2x8(pa, pa + (size_t)16 * FF, h8[0], h8[1], fq); }
    }
};
struct EpiY {
    static constexpr bool PERM = true, HAS_MID = false; static constexpr int MID_T = -1;
    unsigned char* Y; const float* wl;
    __device__ __forceinline__ void mid(f32x4 (&)[2][2][4][2], const Unit&, int, int, int, int) const {}
    __device__ __forceinline__ void operator()(const f32x4 (&acc)[2][2][4][2], const Unit& u, int wr, int wc, int fr, int fq) const {
        asm volatile("" : "+v"(fr), "+v"(fq));
        const int rl0 = wr * 64 + fr; const int col0 = (u.pn & 3) * 256 + wc * 32 + 8 * fq;
        float wv_[2][4];
#pragma unroll
        for (int ai = 0; ai < 2; ++ai)
#pragma unroll
            for (int m = 0; m < 4; ++m) { const int rl = rl0 + ai * HALF + m * 16; wv_[ai][m] = rl < u.rows ? wl[(size_t)u.e * CAP + u.pos0 + rl] * (Y_SCALE / W2_SCALE) : 0.f; }
        asm volatile("" ::: "memory");
#pragma unroll
        for (int ai = 0; ai < 2; ++ai)
#pragma unroll
            for (int mp = 0; mp < 4; mp += 2) { const int rl = rl0 + ai * HALF + mp * 16; const float wa = wv_[ai][mp], wb = wv_[ai][mp + 1];
                unsigned char* pa = Y + (size_t)(u.pm * BM + rl) * D + col0;
#pragma unroll
                for (int bj = 0; bj < 2; ++bj) store2x8(pa + bj * HALF, pa + (size_t)16 * D + bj * HALF, pack8_fp8(acc[ai][bj][mp][0] * wa, acc[ai][bj][mp][1] * wa), pack8_fp8(acc[ai][bj][mp + 1][0] * wb, acc[ai][bj][mp + 1][1] * wb), fq); }
    }
};
}

#define XB_TMO      128
#define XB_XCNT(j)  (256  + 64 * (j))
#define XB_XSUB(j)  (1280 + 64 * (j))
#define XB_XGEN(j)  (2304 + 64 * (j))
#define XB_TOP      3328
#define XB_TOPGEN   3392
#define XCD_BAR_WORDS 3456
#define XB_SPIN_CAP (1u << 18)
__device__ __forceinline__ unsigned xb_ld(unsigned* p)              { return __hip_atomic_load(p, __ATOMIC_RELAXED, __HIP_MEMORY_SCOPE_AGENT); }
__device__ __forceinline__ unsigned xb_add(unsigned* p, unsigned v) { return __hip_atomic_fetch_add(p, v, __ATOMIC_RELAXED, __HIP_MEMORY_SCOPE_AGENT); }
__device__ __forceinline__ unsigned xb_xcc_id() { return (unsigned)__builtin_amdgcn_s_getreg((3 << 11) | 20) & 0xFu; }
#define XB_SPIN(cond, bar) do { unsigned _sp = 0; while (cond) { __builtin_amdgcn_s_sleep(1); \
    if ((++_sp & 255u) == 0u) { if (xb_ld(&(bar)[XB_TMO])) break; if (_sp > XB_SPIN_CAP) { atomicAdd(&(bar)[XB_TMO], 1u); break; } } } } while (0)
struct XcdBarrier { unsigned* bar; unsigned x; volatile LAS unsigned* st; };
__device__ __forceinline__ XcdBarrier xcd_barrier_post(unsigned* bar, volatile LAS unsigned* st) {
    XcdBarrier b; b.bar = bar; b.x = xb_xcc_id(); b.st = st;
    if (threadIdx.x == 0) (void)xb_add(&bar[XB_XCNT(b.x)], 1u);
    return b;
}
__device__ __forceinline__ void xcd_barrier_complete(unsigned* bar, unsigned x, unsigned& nloc, unsigned& nx) {
    const unsigned G = gridDim.x * gridDim.y * gridDim.z;
    unsigned sum, cnt, mine, sp = 0u;
    for (;;) {
        sum = 0u; cnt = 0u; mine = 0u;
#pragma unroll
        for (unsigned j = 0; j < 16; ++j) { const unsigned c = xb_ld(&bar[XB_XCNT(j)]); sum += c; cnt += (c > 0u) ? 1u : 0u; mine = (j == x) ? c : mine; }
        if (sum == G) break;
        __builtin_amdgcn_s_sleep(1);
        if ((++sp & 255u) == 0u) { if (xb_ld(&bar[XB_TMO])) break; if (sp > XB_SPIN_CAP) { atomicAdd(&bar[XB_TMO], 1u); break; } }
    }
    nloc = mine > 0u ? mine : 1u; nx = cnt > 0u ? cnt : 1u;
}
__device__ __forceinline__ void xcd_barrier(const XcdBarrier& b) {
    asm volatile("s_waitcnt vmcnt(0)" ::: "memory");
    __syncthreads();
    if (threadIdx.x == 0) {
        unsigned* bar = b.bar;
        __builtin_amdgcn_s_waitcnt(0);
        unsigned nloc = b.st[0], nx = b.st[1];
        if (nloc == 0u) { xcd_barrier_complete(bar, b.x, nloc, nx); b.st[0] = nloc; b.st[1] = nx; }
        const unsigned old = xb_add(&bar[XB_XSUB(b.x)], 1u);
        const unsigned gen = old / nloc;
        if (old + 1u == (gen + 1u) * nloc) {
            __builtin_amdgcn_fence(__ATOMIC_RELEASE, "agent");
            asm volatile("s_waitcnt vmcnt(0)" ::: "memory");
            const unsigned og = xb_add(&bar[XB_TOP], 1u);
            const unsigned tg = og / nx;
            if (og + 1u == (tg + 1u) * nx) xb_add(&bar[XB_TOPGEN], 1u);
            else XB_SPIN(xb_ld(&bar[XB_TOPGEN]) == tg, bar);
            __builtin_amdgcn_fence(__ATOMIC_ACQUIRE, "agent");
            xb_add(&bar[XB_XGEN(b.x)], 1u);
            asm volatile("s_waitcnt vmcnt(0)" ::: "memory");
        } else {
            XB_SPIN(xb_ld(&bar[XB_XGEN(b.x)]) == gen, bar);
            __builtin_amdgcn_fence(__ATOMIC_ACQUIRE, "agent");
            asm volatile("s_waitcnt vmcnt(0)" ::: "memory");
        }
    }
    __syncthreads();
}

__device__ __forceinline__ void xcd_barrier_arrive(const XcdBarrier& b) {
    asm volatile("s_waitcnt vmcnt(0)" ::: "memory");
    __syncthreads();
    if (threadIdx.x == 0) {
        unsigned* bar = b.bar;
        __builtin_amdgcn_s_waitcnt(0);
        unsigned nloc = b.st[0], nx = b.st[1];
        if (nloc == 0u) { xcd_barrier_complete(bar, b.x, nloc, nx); b.st[0] = nloc; b.st[1] = nx; }
        const unsigned old = xb_add(&bar[XB_XSUB(b.x)], 1u);
        const unsigned gen = old / nloc;
        if (old + 1u == (gen + 1u) * nloc) {
            __builtin_amdgcn_fence(__ATOMIC_RELEASE, "agent");
            asm volatile("s_waitcnt vmcnt(0)" ::: "memory");
            const unsigned og = xb_add(&bar[XB_TOP], 1u);
            const unsigned tg = og / nx;
            if (og + 1u == (tg + 1u) * nx) xb_add(&bar[XB_TOPGEN], 1u);
            else XB_SPIN(xb_ld(&bar[XB_TOPGEN]) == tg, bar);
            __builtin_amdgcn_fence(__ATOMIC_ACQUIRE, "agent");
            xb_add(&bar[XB_XGEN(b.x)], 1u);
            asm volatile("s_waitcnt vmcnt(0)" ::: "memory");
            b.st[2] = 0xffffffffu;
        } else b.st[2] = gen;
    }
}
__device__ __forceinline__ void xcd_barrier_wait(const XcdBarrier& b) {
    if (threadIdx.x == 0) {
        unsigned* bar = b.bar;
        const unsigned gen = b.st[2];
        if (gen != 0xffffffffu) {
            XB_SPIN(xb_ld(&bar[XB_XGEN(b.x)]) == gen, bar);
            __builtin_amdgcn_fence(__ATOMIC_ACQUIRE, "agent");
            asm volatile("s_waitcnt vmcnt(0)" ::: "memory");
        }
    }
    __syncthreads();
}

constexpr int NWAVES = 8;
struct Frame {
    LAS unsigned char* lds;
    gu32* ctl;
    int tid, lane, wave;
    int vcu, G;
    const float *x, *g_mix, *w_in, *b_gate, *conv_w, *w_ao, *w_co, *w_out, *g_ffn, *w_rg, *b_rg, *w_re, *b_re, *w1, *w3, *w2, *g_fin;
    float* out;
    bf16 *WinT, *WacT, *WoT, *PROJ, *XN, *X1B; unsigned char* Y; float* irs1;
    unsigned char *W13Q, *W2Q, *X1Q, *HIDQ, *XNQ, *WinQ;
    int* list; float* wl; float* rsl; int* tokinfo; float* WrT; float* sO; float* sC;
};
__device__ __forceinline__ float wave_sum(float v) {
#pragma unroll
    for (int o = 1; o < 64; o <<= 1) v += __shfl_xor(v, o);
    return v;
}
__device__ __forceinline__ void tr_item(const float* W, int ldw, int k0, int n0, bf16* WT, int ldt, int drow0, int dcol0, const float* rg, float cs, LAS float* scr, int lane) {
    const int kr = lane >> 3, nc = 4 * (lane & 7);
    f32x4 v[8]; float sc[8];
#pragma unroll
    for (int i = 0; i < 8; ++i) v[i] = __builtin_nontemporal_load((const GAS f32x4*)(W + (size_t)(k0 + 8 * i + kr) * ldw + n0 + nc));
#pragma unroll
    for (int i = 0; i < 8; ++i) sc[i] = rg ? rg[k0 + 8 * i + kr] * cs : cs;
#pragma unroll
    for (int i = 0; i < 8; ++i) { LAS float* d = scr + (8 * i + kr) * 33 + nc; const f32x4 t = v[i] * sc[i]; d[0] = t.x; d[1] = t.y; d[2] = t.z; d[3] = t.w; }
    LDS_WAIT(); asm volatile("" ::: "memory");
    const int c = lane & 7;
#pragma unroll
    for (int j = 0; j < 4; ++j) { const int n = (lane >> 3) + 8 * j; const LAS float* s = scr + (8 * c) * 33 + n;
        v4u o; o.x = pk2(s[0 * 33], s[1 * 33]); o.y = pk2(s[2 * 33], s[3 * 33]); o.z = pk2(s[4 * 33], s[5 * 33]); o.w = pk2(s[6 * 33], s[7 * 33]);
        *(GAS v4u*)(WT + (size_t)(drow0 + n) * ldt + dcol0 + 8 * c) = o; }
    LDS_WAIT(); asm volatile("" ::: "memory");
}
__device__ __forceinline__ void tr_item_q(const float* W, int ldw, int k0, int n0, unsigned char* WT, int ldt, int drow0, int dcol0, const float* rg, float cs, LAS float* scr, int lane) {
    const int kr = lane >> 3, nc = 4 * (lane & 7);
    f32x4 v[8]; float sc[8];
#pragma unroll
    for (int i = 0; i < 8; ++i) v[i] = __builtin_nontemporal_load((const GAS f32x4*)(W + (size_t)(k0 + 8 * i + kr) * ldw + n0 + nc));
#pragma unroll
    for (int i = 0; i < 8; ++i) sc[i] = rg ? rg[k0 + 8 * i + kr] * cs : cs;
#pragma unroll
    for (int i = 0; i < 8; ++i) { LAS float* d = scr + (8 * i + kr) * 33 + nc; const f32x4 t = v[i] * sc[i]; d[0] = t.x; d[1] = t.y; d[2] = t.z; d[3] = t.w; }
    LDS_WAIT(); asm volatile("" ::: "memory");
    const int c = lane & 7;
#pragma unroll
    for (int j = 0; j < 4; ++j) { const int n = (lane >> 3) + 8 * j; const LAS float* s = scr + (8 * c) * 33 + n;
        const f32x4 a = {s[0 * 33], s[1 * 33], s[2 * 33], s[3 * 33]}, b = {s[4 * 33], s[5 * 33], s[6 * 33], s[7 * 33]};
        *(GAS pg8::u32x2*)(WT + (size_t)(drow0 + n) * ldt + dcol0 + 8 * c) = pg8::pack8_fp8(a, b); }
    LDS_WAIT(); asm volatile("" ::: "memory");
}
template <bool HAD = false>
__device__ __forceinline__ void tr_item_i8(const float* W, int ldw, int k0, int n0, unsigned char* WT, int ldt, int drow0, int dcol0, const float* rg, float cs, LAS float* scr, int lane) {
    const int kr = lane >> 3, nc = 4 * (lane & 7);
    f32x4 v[8]; float sc[8];
#pragma unroll
    for (int i = 0; i < 8; ++i) v[i] = __builtin_nontemporal_load((const GAS f32x4*)(W + (size_t)(k0 + 8 * i + kr) * ldw + n0 + nc));
    if constexpr (HAD) {
#pragma unroll
        for (int h = 0; h < 8; h += 4) { const f32x4 s0 = v[h] + v[h + 1], s1 = v[h] - v[h + 1], s2 = v[h + 2] + v[h + 3], s3 = v[h + 2] - v[h + 3]; v[h] = s0 + s2; v[h + 1] = s1 + s3; v[h + 2] = s0 - s2; v[h + 3] = s1 - s3; }
#pragma unroll
        for (int M = 8; M < 64; M <<= 1)
#pragma unroll
            for (int i = 0; i < 8; ++i) { f32x4 p; p.x = __shfl_xor(v[i].x, M); p.y = __shfl_xor(v[i].y, M); p.z = __shfl_xor(v[i].z, M); p.w = __shfl_xor(v[i].w, M); v[i] = (lane & M) ? p - v[i] : v[i] + p; }
        cs *= 0.17677669529663687f;
    }
#pragma unroll
    for (int i = 0; i < 8; ++i) sc[i] = rg ? rg[k0 + 8 * i + kr] * cs : cs;
#pragma unroll
    for (int i = 0; i < 8; ++i) { LAS float* d = scr + (8 * i + kr) * 33 + nc; const f32x4 t = v[i] * sc[i]; d[0] = t.x; d[1] = t.y; d[2] = t.z; d[3] = t.w; }
    LDS_WAIT(); asm volatile("" ::: "memory");
    const int c = lane & 7;
#pragma unroll
    for (int j = 0; j < 4; ++j) { const int n = (lane >> 3) + 8 * j; const LAS float* s = scr + (8 * c) * 33 + n;
        v2u o; o.x = pack4_i8(s[0 * 33], s[1 * 33], s[2 * 33], s[3 * 33]); o.y = pack4_i8(s[4 * 33], s[5 * 33], s[6 * 33], s[7 * 33]);
        *(GAS v2u*)(WT + (size_t)(drow0 + n) * ldt + dcol0 + 8 * c) = o; }
    LDS_WAIT(); asm volatile("" ::: "memory");
}
__device__ __forceinline__ int win_dst(int n) {
    if (n < 256) return n;
    if (n < 512) return PC_Q1 + (n - 256);
    if (n < 768) return PC_Q2 + (n - 512);
    if (n < 1536) { const int c = n - 768; return PC_K + (c >> 6) * 128 + (c & 63); }
    if (n < 2304) { const int c = n - 1536; return PC_K + (c >> 6) * 128 + 64 + (c & 63); }
    if (n < 3072) return PC_BG + (n - 2304);
    if (n < 3840) { const int i = (n - 3072) >> 7, w = (n - 3072) & 127; return 3072 + 256 * i + w; }
    if (n < 4608) { const int i = (n - 3840) >> 7, w = (n - 3840) & 127; return 3072 + 256 * i + 128 + w; }
    return n;
}
__device__ __forceinline__ void p0_prologue(Frame& F) {
    LAS float* scr = (LAS float*)(F.lds + F.wave * 16384);
    const int gw = F.vcu * NWAVES + F.wave, NGW = F.G * NWAVES;
    constexpr int I_IN = (D / 64) * (NPROJ / 32), I_AO = (256 / 64) * (D / 32), I_CO = (768 / 64) * (D / 32), I_O = (D / 64) * (D / 32);
    constexpr int NITEMS = I_IN + I_AO + I_CO + I_O;
    for (int it = gw; it < NITEMS; it += NGW) {
        int r = it;
        if (r < I_IN) { const int nb = r % (NPROJ / 32), kb = r / (NPROJ / 32); const int n0 = 32 * nb;
            tr_item_i8(F.w_in, NPROJ, 64 * kb, n0, (unsigned char*)F.WinT, D, win_dst(n0), 64 * kb, F.g_mix, 127.0f / W8_CLIP, scr, F.lane);
            continue; }
        r -= I_IN;
        if (r < I_AO) { const int nb = r % (D / 32), kb = r / (D / 32); tr_item_i8(F.w_ao, D, 64 * kb, 32 * nb, (unsigned char*)F.WacT, WAC_LDB, 32 * nb, 64 * kb, nullptr, 127.0f / WA8_CLIP, scr, F.lane); continue; }
        r -= I_AO;
        if (r < I_CO) { const int nb = r % (D / 32), kb = r / (D / 32); tr_item_i8<true>(F.w_co, D, 64 * kb, 32 * nb, (unsigned char*)F.WacT, WAC_LDB, 32 * nb, 256 + 64 * kb, nullptr, 127.0f / WC8_CLIP, scr, F.lane); continue; }
        r -= I_CO;
        { const int nb = r % (D / 32), kb = r / (D / 32); tr_item_i8(F.w_out, D, 64 * kb, 32 * nb, (unsigned char*)F.WoT, D, 32 * nb, 64 * kb, nullptr, 127.0f / W8_CLIP, scr, F.lane); }
    }
    for (int idx = gw * 64 + F.lane; idx < 48 * D / 2; idx += NGW * 64) { const int c = idx >> 9, k = (idx & (D / 2 - 1)) * 2;
        float w0 = 0.f, w1 = 0.f; if (c < 4) { w0 = F.w_rg[k * 4 + c]; w1 = F.w_rg[(k + 1) * 4 + c]; } else if (c < 36) { w0 = F.w_re[k * 32 + (c - 4)]; w1 = F.w_re[(k + 1) * 32 + (c - 4)]; }
        ((unsigned*)F.WrT)[idx] = pk2(w0 * F.g_ffn[k], w1 * F.g_ffn[k + 1]); }
    for (int m4 = gw * 4; m4 < T; m4 += NGW * 4) {
        f32x4 v[4][4]; float sq[4];
#pragma unroll
        for (int q = 0; q < 4; ++q) { const GAS f32x4* xr = (const GAS f32x4*)(F.x + (size_t)(m4 + q) * D) + F.lane;
#pragma unroll
            for (int j = 0; j < 4; ++j) v[q][j] = __builtin_nontemporal_load(xr + 64 * j); }
#pragma unroll
        for (int q = 0; q < 4; ++q) { float s = 0.f;
#pragma unroll
            for (int j = 0; j < 4; ++j) s += (v[q][j].x * v[q][j].x + v[q][j].y * v[q][j].y) + (v[q][j].z * v[q][j].z + v[q][j].w * v[q][j].w);
            sq[q] = s; }
#pragma unroll
        for (int o = 1; o < 64; o <<= 1) {
#pragma unroll
            for (int q = 0; q < 4; ++q) sq[q] += __shfl_xor(sq[q], o); }
        float mx[4];
#pragma unroll
        for (int q = 0; q < 4; ++q) { float m_ = 0.f;
#pragma unroll
            for (int j = 0; j < 4; ++j) m_ = fmaxf(fmaxf(fmaxf(fabsf(v[q][j].x), fabsf(v[q][j].y)), fmaxf(fabsf(v[q][j].z), fabsf(v[q][j].w))), m_);
            mx[q] = m_; }
#pragma unroll
        for (int o = 1; o < 64; o <<= 1) {
#pragma unroll
            for (int q = 0; q < 4; ++q) mx[q] = fmaxf(mx[q], __shfl_xor(mx[q], o)); }
#pragma unroll
        for (int q = 0; q < 4; ++q) { const float rstd = 1.0f / sqrtf(sq[q] * (1.f / D) + RMS_EPS);
            const float amax = fmaxf(mx[q] * rstd, 1e-20f), sxv = amax * (1.0f / 127.0f), qs = rstd * (127.0f / amax);
            if (F.lane == 0) F.irs1[m4 + q] = sxv;
            GAS unsigned* o4 = (GAS unsigned*)(F.XNQ + (size_t)(m4 + q) * D) + F.lane;
#pragma unroll
            for (int j = 0; j < 4; ++j) o4[64 * j] = pack4_i8(v[q][j].x * qs, v[q][j].y * qs, v[q][j].z * qs, v[q][j].w * qs); }
    }
}

__device__ __forceinline__ void store2x8_x1(unsigned char* pa, unsigned char* pb, const pg8::u32x2 A, const pg8::u32x2 B, int lane) {
    const bool odd = lane & 1;
    const unsigned sx = odd ? A.x : B.x, sy = odd ? A.y : B.y;
    const unsigned rx = (unsigned)__builtin_amdgcn_update_dpp((int)sx, (int)sx, 0xB1, 0xf, 0xf, false), ry = (unsigned)__builtin_amdgcn_update_dpp((int)sy, (int)sy, 0xB1, 0xf, 0xf, false);
    const v4u w = odd ? (v4u){rx, ry, B.x, B.y} : (v4u){A.x, A.y, rx, ry};
    *(GAS v4u*)(odd ? pb - 8 : pa) = w;
}
__device__ __forceinline__ void p2_conv(Frame& F) {
    const int gw = F.vcu * NWAVES + F.wave, NGW = F.G * NWAVES;
    for (int t4 = gw * 4; t4 < T; t4 += NGW * 4) {
        const int s0 = t4 & (SEQ - 1);
        float ssq[4] = {0.f, 0.f, 0.f, 0.f}, mx[4] = {0.f, 0.f, 0.f, 0.f};
        float cv[4][3][4];
#pragma unroll
        for (int it = 0; it < 3; ++it) { const int ch = 4 * F.lane + 256 * it;
            const unsigned char* up = (const unsigned char*)(F.PROJ + (size_t)t4 * PROJ_LD + PC_U) + ch; const bf16* bp = F.PROJ + (size_t)t4 * PROJ_LD + PC_BG + ch;
            unsigned u[6]; v2u bg[4];
#pragma unroll
            for (int q = 0; q < 6; ++q) { const int sq = s0 - 1 + q; u[q] = 0u; if (sq >= 0 && sq < SEQ) u[q] = *(const GAS unsigned*)(up + (ptrdiff_t)(q - 1) * (PROJ_LD * 2)); }
#pragma unroll
            for (int q = 0; q < 4; ++q) bg[q] = *(const GAS v2u*)(bp + q * PROJ_LD);
            const f32x4 w0 = *(const GAS f32x4*)(F.conv_w + ch) * (1.0f / U_SCALE), w1 = *(const GAS f32x4*)(F.conv_w + 768 + ch) * (1.0f / U_SCALE), w2 = *(const GAS f32x4*)(F.conv_w + 1536 + ch) * (1.0f / U_SCALE);
            pg8::f32x2_t ulo[6], uhi[6];
#pragma unroll
            for (int q = 0; q < 6; ++q) { ulo[q] = __builtin_amdgcn_cvt_pk_f32_fp8((int)u[q], false); uhi[q] = __builtin_amdgcn_cvt_pk_f32_fp8((int)u[q], true); }
#pragma unroll
            for (int q = 0; q < 4; ++q) {
                float c0 = bflo(bg[q].x) * (w0.x * ulo[q][0] + w1.x * ulo[q + 1][0] + w2.x * ulo[q + 2][0]);
                float c1 = bfhi(bg[q].x) * (w0.y * ulo[q][1] + w1.y * ulo[q + 1][1] + w2.y * ulo[q + 2][1]);
                float c2 = bflo(bg[q].y) * (w0.z * uhi[q][0] + w1.z * uhi[q + 1][0] + w2.z * uhi[q + 2][0]);
                float c3 = bfhi(bg[q].y) * (w0.w * uhi[q][1] + w1.w * uhi[q + 1][1] + w2.w * uhi[q + 2][1]);
                ssq[q] += (c0 * c0 + c1 * c1) + (c2 * c2 + c3 * c3);
                { const float a0 = c0 + c1, a1 = c0 - c1, a2 = c2 + c3, a3 = c2 - c3; c0 = a0 + a2; c1 = a1 + a3; c2 = a0 - a2; c3 = a1 - a3; }
#pragma unroll
                for (int M = 1; M < 8; M <<= 1) { const float p0 = __shfl_xor(c0, M), p1 = __shfl_xor(c1, M), p2 = __shfl_xor(c2, M), p3 = __shfl_xor(c3, M); const bool up_ = (F.lane & M) != 0;
                    c0 = up_ ? p0 - c0 : c0 + p0; c1 = up_ ? p1 - c1 : c1 + p1; c2 = up_ ? p2 - c2 : c2 + p2; c3 = up_ ? p3 - c3 : c3 + p3; }
                cv[q][it][0] = c0; cv[q][it][1] = c1; cv[q][it][2] = c2; cv[q][it][3] = c3;
                mx[q] = fmaxf(mx[q], fmaxf(fmaxf(fabsf(c0), fabsf(c1)), fmaxf(fabsf(c2), fabsf(c3)))); } }
#pragma unroll
        for (int o = 1; o < 64; o <<= 1) {
#pragma unroll
            for (int q = 0; q < 4; ++q) { ssq[q] += __shfl_xor(ssq[q], o); mx[q] = fmaxf(mx[q], __shfl_xor(mx[q], o)); } }
#pragma unroll
        for (int q = 0; q < 4; ++q) { const float amax = fmaxf(mx[q], 1e-20f), qs = 127.0f / amax;
            if (F.lane == 0) { F.sC[t4 + q] = amax * (0.17677669529663687f / 127.0f);
                F.irs1[t4 + q] = fmaxf(MERGED_CLIP * sqrtf(ssq[q] * (1.0f / 768.0f)), 1e-20f) * (1.0f / 127.0f); }
            GAS unsigned* o4 = (GAS unsigned*)((unsigned char*)(F.PROJ + (size_t)(t4 + q) * PROJ_LD) + 512) + F.lane;
#pragma unroll
            for (int it = 0; it < 3; ++it) o4[64 * it] = pack4_i8(cv[q][it][0] * qs, cv[q][it][1] * qs, cv[q][it][2] * qs, cv[q][it][3] * qs); }
    }
}
__device__ __forceinline__ void p2_attn_naive(Frame& F) {
    for (int blk = F.vcu; blk < T / 128; blk += F.G) {
        const int t = blk * 128 + (F.tid & 127), j = F.tid >> 7;
        const int b = t / SEQ, s = t % SEQ;
        float o[64];
#pragma unroll
        for (int e = 0; e < 64; ++e) o[e] = 0.f;
        float mx = -1e30f, l = 0.f;
        for (int g = 0; g < 3; ++g) {
            const int dil = g == 0 ? 1 : (g == 1 ? 4 : 16);
            const int qc = (g == 0 ? PC_Q0 : (g == 1 ? PC_Q1 : PC_Q2)) + 64 * j;
            const float slope2 = exp2f(-8.0f * (float)(4 * g + j + 1) / 12.0f) * LOG2E * (float)dil;
            float q[64];
            { const bf16* qp = F.PROJ + (size_t)t * PROJ_LD + qc;
#pragma unroll
              for (int c = 0; c < 8; ++c) { const v4u w = *(const GAS v4u*)(qp + 8 * c);
#pragma unroll
                  for (int z = 0; z < 4; ++z) { q[8 * c + 2 * z] = bflo(w[z]); q[8 * c + 2 * z + 1] = bfhi(w[z]); } } }
            for (int dl = -64; dl <= 64; ++dl) {
                const int s2 = s + dl * dil;
                if (s2 < 0 || s2 >= SEQ) continue;
                const bf16* kp = F.PROJ + (size_t)(b * SEQ + s2) * PROJ_LD + PC_K + g * 256 + 64 * j;
                float dot = 0.f;
#pragma unroll
                for (int c = 0; c < 8; ++c) { const v4u w = *(const GAS v4u*)(kp + 8 * c);
#pragma unroll
                    for (int z = 0; z < 4; ++z) dot += q[8 * c + 2 * z] * bflo(w[z]) + q[8 * c + 2 * z + 1] * bfhi(w[z]); }
                const float sc = dot - slope2 * (float)(dl < 0 ? -dl : dl);
                const float mn = fmaxf(mx, sc);
                const float alpha = fast_exp2(mx - mn), p = fast_exp2(sc - mn);
                mx = mn; l = l * alpha + p;
                const bf16* vp = kp + (PC_V - PC_K);
#pragma unroll
                for (int c = 0; c < 8; ++c) { const v4u w = *(const GAS v4u*)(vp + 8 * c);
#pragma unroll
                    for (int z = 0; z < 4; ++z) { o[8 * c + 2 * z] = o[8 * c + 2 * z] * alpha + p * bflo(w[z]); o[8 * c + 2 * z + 1] = o[8 * c + 2 * z + 1] * alpha + p * bfhi(w[z]); } }
            }
        }
        const float inv = 1.0f / l;
        bf16* op = F.PROJ + (size_t)t * PROJ_LD + PC_O + 64 * j;
#pragma unroll
        for (int c = 0; c < 8; ++c) { v4u w;
#pragma unroll
            for (int z = 0; z < 4; ++z) w[z] = pk2(o[8 * c + 2 * z] * inv, o[8 * c + 2 * z + 1] * inv);
            *(GAS v4u*)(op + 8 * c) = w; }
    }
}


typedef float f32x16 __attribute__((ext_vector_type(16)));
typedef short bf16x8v __attribute__((ext_vector_type(8)));
typedef short s16x4 __attribute__((ext_vector_type(4)));
typedef short v4i16_t __attribute__((ext_vector_type(4)));
__device__ __forceinline__ int crow(int r, int hi) { return (r & 3) + 8 * (r >> 2) + 4 * hi; }
__device__ __forceinline__ s16x4 tr_read(const LAS unsigned char* p) { return __builtin_bit_cast(s16x4, __builtin_amdgcn_ds_read_tr16_b64_v4i16((LAS v4i16_t*)p)); }
__device__ __forceinline__ void attn_unit(Frame& F, int u, LAS unsigned char* vl, float* lse) {
    const int lane = F.lane, r32 = lane & 31, hi = lane >> 5;
    const int g = u >> 12, rem = u & 4095, j = rem >> 10, st = rem & 1023;
    const int sh = 2 * g, dil = 1 << sh, L = SEQ >> sh;
    const int b = st >> 8, w = st & 255, r = w >> (8 - sh), ti = w & ((256 >> sh) - 1);
    const int i0 = 32 * ti;
    const size_t rowbase = (size_t)b * SEQ + r;
    const int qcol = (g == 0 ? PC_Q0 : (g == 1 ? PC_Q1 : PC_Q2)) + 64 * j;
    const bf16* kbase = F.PROJ + PC_K + g * 256 + 64 * j;
    const float slope2 = exp2f(-8.0f * (float)(4 * g + j + 1) / 12.0f) * LOG2E * (float)dil;
    const size_t qrow = rowbase + (size_t)(i0 + r32) * dil;
    bf16x8v qr[4];
    { const bf16* qp = F.PROJ + qrow * PROJ_LD + qcol + 8 * hi;
#pragma unroll
      for (int d0 = 0; d0 < 4; ++d0) qr[d0] = *(const GAS bf16x8v*)(qp + 16 * d0); }
    f32x16 p[5];
#pragma unroll
    for (int kt = 0; kt < 5; ++kt) {
        int pos = i0 - 64 + 32 * kt + r32; pos = pos < 0 ? 0 : (pos > L - 1 ? L - 1 : pos);
        const bf16* kp = kbase + (rowbase + (size_t)pos * dil) * PROJ_LD + 8 * hi;
        bf16x8v kf[4];
#pragma unroll
        for (int d0 = 0; d0 < 4; ++d0) kf[d0] = *(const GAS bf16x8v*)(kp + 16 * d0);
        f32x16 a = {0.f, 0.f, 0.f, 0.f, 0.f, 0.f, 0.f, 0.f, 0.f, 0.f, 0.f, 0.f, 0.f, 0.f, 0.f, 0.f};
#pragma unroll
        for (int d0 = 0; d0 < 4; ++d0) a = __builtin_amdgcn_mfma_f32_32x32x16_bf16(kf[d0], qr[d0], a, 0, 0, 0);
        p[kt] = a;
    }
    float mloc = -1e30f;
    const float dbase = (float)(4 * hi - r32 - 64);
#pragma unroll
    for (int kt = 0; kt < 5; ++kt)
#pragma unroll
        for (int rr = 0; rr < 16; ++rr) {
            const float d = dbase + (float)(32 * kt + (rr & 3) + 8 * (rr >> 2));
            float sv = p[kt][rr] - slope2 * fabsf(d);
            if (kt == 0) sv = d >= -64.0f ? sv : -1e30f;
            if (kt == 4) sv = d <= 64.0f ? sv : -1e30f;
            p[kt][rr] = sv;
        }
    if (i0 < 64 || i0 + 96 > L) {
#pragma unroll
        for (int kt = 0; kt < 5; ++kt)
#pragma unroll
            for (int rr = 0; rr < 16; ++rr) { const int pos = i0 - 64 + 32 * kt + crow(rr, hi); p[kt][rr] = (pos >= 0 && pos < L) ? p[kt][rr] : -1e30f; }
    }
#pragma unroll
    for (int kt = 0; kt < 5; ++kt)
#pragma unroll
        for (int rr = 0; rr < 16; ++rr) mloc = fmaxf(mloc, p[kt][rr]);
    const float mrow = fmaxf(mloc, __shfl_xor(mloc, 32));
    float lsum = 0.f;
#pragma unroll
    for (int kt = 0; kt < 5; ++kt)
#pragma unroll
        for (int rr = 0; rr < 16; ++rr) { const float e = fast_exp2(p[kt][rr] - mrow); p[kt][rr] = e; lsum += e; }
    const float lrow = lsum + __shfl_xor(lsum, 32);
    bf16x8v pb[5][2];
#pragma unroll
    for (int kt = 0; kt < 5; ++kt)
#pragma unroll
        for (int s2 = 0; s2 < 2; ++s2) { v4u wv;
#pragma unroll
            for (int q = 0; q < 4; ++q) wv[q] = pg8::cvt_pk_bf16(p[kt][8 * s2 + 2 * q], p[kt][8 * s2 + 2 * q + 1]);
            pb[kt][s2] = __builtin_bit_cast(bf16x8v, wv); }
    f32x16 o[2];
#pragma unroll
    for (int db = 0; db < 2; ++db) o[db] = (f32x16){0.f, 0.f, 0.f, 0.f, 0.f, 0.f, 0.f, 0.f, 0.f, 0.f, 0.f, 0.f, 0.f, 0.f, 0.f, 0.f};
    const bf16* vbase = kbase + (PC_V - PC_K);
    const LAS unsigned char* vrd = vl + (4 * hi + ((lane & 15) >> 2)) * 128 + ((lane >> 4) & 1) * 32 + (lane & 3) * 8;
#pragma unroll
    for (int kt = 0; kt < 5; ++kt) {
        v4u vv[4];
#pragma unroll
        for (int i = 0; i < 4; ++i) { int pos = i0 - 64 + 32 * kt + 8 * i + (lane >> 3); pos = pos < 0 ? 0 : (pos > L - 1 ? L - 1 : pos);
            vv[i] = *(const GAS v4u*)(vbase + (rowbase + (size_t)pos * dil) * PROJ_LD + 8 * (lane & 7)); }
        asm volatile("" ::: "memory");
#pragma unroll
        for (int i = 0; i < 4; ++i) *(LAS v4u*)(vl + (8 * i + (lane >> 3)) * 128 + (lane & 7) * 16) = vv[i];
        asm volatile("" ::: "memory");
#pragma unroll
        for (int db = 0; db < 2; ++db)
#pragma unroll
            for (int s2 = 0; s2 < 2; ++s2) {
                const s16x4 lo = tr_read(vrd + (16 * s2) * 128 + db * 64), hh = tr_read(vrd + (16 * s2 + 8) * 128 + db * 64);
                const bf16x8v vf = (bf16x8v){lo[0], lo[1], lo[2], lo[3], hh[0], hh[1], hh[2], hh[3]};
                o[db] = __builtin_amdgcn_mfma_f32_32x32x16_bf16(vf, pb[kt][s2], o[db], 0, 0, 0);
            }
        asm volatile("" ::: "memory");
    }
    const float inv = 1.0f / lrow;
    bf16* op = F.X1B + qrow * 768 + g * 256 + 64 * j + 4 * hi;
#pragma unroll
    for (int db = 0; db < 2; ++db)
#pragma unroll
        for (int rg = 0; rg < 4; ++rg) { v2u wv; wv.x = pg8::cvt_pk_bf16(o[db][4 * rg] * inv, o[db][4 * rg + 1] * inv); wv.y = pg8::cvt_pk_bf16(o[db][4 * rg + 2] * inv, o[db][4 * rg + 3] * inv);
            *(GAS v2u*)(op + 32 * db + 8 * rg) = wv; }
    if (hi == 0) lse[qrow * 12 + g * 4 + j] = mrow + log2f(lrow);
}
struct AttnItem { int g, j, sh, L, c0; size_t rowbase; };
__device__ __forceinline__ AttnItem attn_decode(int it) {
    AttnItem a; a.g = it >> 9; const int rem = it & 511; a.j = rem >> 7; const int sq = rem & 127; const int b = sq >> 5, w = sq & 31;
    a.sh = 2 * a.g; a.L = SEQ >> a.sh; const int r = w >> (5 - a.sh), ci = w & ((32 >> a.sh) - 1); a.c0 = 256 * ci; a.rowbase = (size_t)b * SEQ + r; return a;
}
__device__ __forceinline__ void attn_fetch(Frame& F, const AttnItem& a, v4u (&R)[6]) {
    const unsigned char* base = (const unsigned char*)(F.PROJ + PC_K) + (a.g * 4 + a.j) * 128;
    int tid = F.tid; asm volatile("" : "+v"(tid));
#pragma unroll
    for (int k = 0; k < 6; ++k) { const int id = tid + 512 * k, row = id >> 3, c8 = id & 7;
        int pos = a.c0 - 64 + row; pos = pos < 0 ? 0 : (pos > a.L - 1 ? a.L - 1 : pos);
        R[k] = *(const GAS v4u*)(base + (a.rowbase + ((size_t)pos << a.sh)) * (size_t)(PROJ_LD * 2) + 16 * c8); }
}
__device__ __forceinline__ void attn_commit(Frame& F, const v4u (&R)[6], LAS unsigned char* kimg, LAS unsigned char* vimg) {
    int tid = F.tid; asm volatile("" : "+v"(tid));
#pragma unroll
    for (int k = 0; k < 6; ++k) { const int id = tid + 512 * k, row = id >> 3, c8 = id & 7, c4 = c8 & 3;
        unsigned w[8];
#pragma unroll
        for (int q = 0; q < 4; ++q) { const pg8::f32x2_t lo = __builtin_amdgcn_cvt_pk_f32_fp8((int)R[k][q], false), hi = __builtin_amdgcn_cvt_pk_f32_fp8((int)R[k][q], true);
            w[2 * q] = pg8::cvt_pk_bf16(lo[0], lo[1]); w[2 * q + 1] = pg8::cvt_pk_bf16(hi[0], hi[1]); }
        const int sw = ((row & 2) << 1) | ((row >> 2) & 3);
        LAS unsigned char* img = ((c8 & 4) ? vimg : kimg) + row * 128;
        *(LAS v4u*)(img + (((2 * c4) ^ sw) << 4)) = (v4u){w[0], w[1], w[2], w[3]};
        *(LAS v4u*)(img + (((2 * c4 + 1) ^ sw) << 4)) = (v4u){w[4], w[5], w[6], w[7]}; }
}
__device__ __forceinline__ void p2_attn_v2(Frame& F) {
    LAS unsigned char* kimg = F.lds; LAS unsigned char* vimg = F.lds + 49152;
    float* lse = (float*)F.list;
    const int lane = F.lane, r32 = lane & 31, hi = lane >> 5, w = F.wave;
    const int swk = ((r32 & 2) << 1) | ((r32 >> 2) & 3);
    const LAS unsigned char* kb = kimg + (32 * w + r32) * 128;
    int koff[4];
#pragma unroll
    for (int d0 = 0; d0 < 4; ++d0) koff[d0] = ((2 * d0 + hi) ^ swk) << 4;
    const int qp_ = (lane & 15) >> 2, pp_ = lane & 3, gh = (lane >> 4) & 1;
    const LAS unsigned char* vad[2][2];
#pragma unroll
    for (int a = 0; a < 2; ++a)
#pragma unroll
        for (int db = 0; db < 2; ++db) { const int sw = ((qp_ & 2) << 1) | ((2 * a + hi) & 3); const int cb = 4 * db + 2 * gh + (pp_ >> 1);
            vad[a][db] = vimg + (32 * w + 8 * a + 4 * hi + qp_) * 128 + ((cb ^ sw) << 4) + (pp_ & 1) * 8; }
    int it = F.vcu;
    v4u R[6];
    bf16x8v qr[4]; v2u qraw[4];
#define ATTN_LOAD_Q(item) do { const AttnItem aq_ = attn_decode(item); const int qcol_ = (aq_.g == 0 ? PC_Q0 : (aq_.g == 1 ? PC_Q1 : PC_Q2)); \
        const unsigned char* qp_g = (const unsigned char*)(F.PROJ + (aq_.rowbase + ((size_t)(aq_.c0 + 32 * w + r32) << aq_.sh)) * PROJ_LD + qcol_) + 64 * aq_.j + 8 * hi; \
        _Pragma("unroll") for (int d0 = 0; d0 < 4; ++d0) qraw[d0] = *(const GAS v2u*)(qp_g + 16 * d0); } while (0)
#define ATTN_CVT_Q() do { _Pragma("unroll") for (int d0 = 0; d0 < 4; ++d0) { v4u wq_; \
        { const pg8::f32x2_t lo_ = __builtin_amdgcn_cvt_pk_f32_fp8((int)qraw[d0].x, false), hi_ = __builtin_amdgcn_cvt_pk_f32_fp8((int)qraw[d0].x, true); wq_.x = pg8::cvt_pk_bf16(lo_[0], lo_[1]); wq_.y = pg8::cvt_pk_bf16(hi_[0], hi_[1]); } \
        { const pg8::f32x2_t lo_ = __builtin_amdgcn_cvt_pk_f32_fp8((int)qraw[d0].y, false), hi_ = __builtin_amdgcn_cvt_pk_f32_fp8((int)qraw[d0].y, true); wq_.z = pg8::cvt_pk_bf16(lo_[0], lo_[1]); wq_.w = pg8::cvt_pk_bf16(hi_[0], hi_[1]); } \
        qr[d0] = __builtin_bit_cast(bf16x8v, wq_); } } while (0)
    if (it < 1536) { const AttnItem a0 = attn_decode(it); attn_fetch(F, a0, R); ATTN_LOAD_Q(it); }
    for (; it < 1536; it += F.G) {
        const AttnItem a = attn_decode(it);
        const int dil = 1 << a.sh, L = a.L, i0 = a.c0 + 32 * w;
        const float slope2 = exp2f(-8.0f * (float)(4 * a.g + a.j + 1) / 12.0f) * LOG2E * (float)dil;
        const size_t qrow = a.rowbase + (size_t)(i0 + r32) * dil;
        attn_commit(F, R, kimg, vimg);
        asm volatile("s_waitcnt lgkmcnt(0)" ::: "memory");
        __builtin_amdgcn_s_barrier(); asm volatile("" ::: "memory");
        if (it + F.G < 1536) { const AttnItem an = attn_decode(it + F.G); attn_fetch(F, an, R); }
        ATTN_CVT_Q();
        f32x16 p[5];
#pragma unroll
        for (int kt = 0; kt < 5; ++kt) {
            bf16x8v kf[4];
#pragma unroll
            for (int d0 = 0; d0 < 4; ++d0) kf[d0] = *(const LAS bf16x8v*)(kb + kt * 4096 + koff[d0]);
            f32x16 acc = {0.f, 0.f, 0.f, 0.f, 0.f, 0.f, 0.f, 0.f, 0.f, 0.f, 0.f, 0.f, 0.f, 0.f, 0.f, 0.f};
#pragma unroll
            for (int d0 = 0; d0 < 4; ++d0) acc = __builtin_amdgcn_mfma_f32_32x32x16_bf16(kf[d0], qr[d0], acc, 0, 0, 0);
            p[kt] = acc;
        }
        if (it + F.G < 1536) ATTN_LOAD_Q(it + F.G);
        float mloc = -1e30f;
        float dbase = (float)(4 * hi - r32 - 64);
        asm volatile("" : "+v"(dbase));
#pragma unroll
        for (int kt = 0; kt < 5; ++kt)
#pragma unroll
            for (int rr = 0; rr < 16; ++rr) {
                const float d = dbase + (float)(32 * kt + (rr & 3) + 8 * (rr >> 2));
                float sv = p[kt][rr] - slope2 * fabsf(d);
                if (kt == 0) sv = d >= -64.0f ? sv : -1e30f;
                if (kt == 4) sv = d <= 64.0f ? sv : -1e30f;
                p[kt][rr] = sv;
            }
        if (i0 < 64 || i0 + 96 > L) {
#pragma unroll
            for (int kt = 0; kt < 5; ++kt)
#pragma unroll
                for (int rr = 0; rr < 16; ++rr) { const int pos = i0 - 64 + 32 * kt + crow(rr, hi); p[kt][rr] = (pos >= 0 && pos < L) ? p[kt][rr] : -1e30f; }
        }
#pragma unroll
        for (int kt = 0; kt < 5; ++kt)
#pragma unroll
            for (int rr = 0; rr < 16; ++rr) mloc = fmaxf(mloc, p[kt][rr]);
        const float mrow = fmaxf(mloc, __shfl_xor(mloc, 32));
        float lsum = 0.f;
#pragma unroll
        for (int kt = 0; kt < 5; ++kt)
#pragma unroll
            for (int rr = 0; rr < 16; ++rr) { const float e = fast_exp2(p[kt][rr] - mrow); p[kt][rr] = e; lsum += e; }
        const float lrow = lsum + __shfl_xor(lsum, 32);
        bf16x8v pb[5][2];
#pragma unroll
        for (int kt = 0; kt < 5; ++kt)
#pragma unroll
            for (int s2 = 0; s2 < 2; ++s2) { v4u wv;
#pragma unroll
                for (int q = 0; q < 4; ++q) wv[q] = pg8::cvt_pk_bf16(p[kt][8 * s2 + 2 * q], p[kt][8 * s2 + 2 * q + 1]);
                pb[kt][s2] = __builtin_bit_cast(bf16x8v, wv); }
        f32x16 o[2];
#pragma unroll
        for (int db = 0; db < 2; ++db) o[db] = (f32x16){0.f, 0.f, 0.f, 0.f, 0.f, 0.f, 0.f, 0.f, 0.f, 0.f, 0.f, 0.f, 0.f, 0.f, 0.f, 0.f};
#pragma unroll
        for (int kt = 0; kt < 5; ++kt)
#pragma unroll
            for (int db = 0; db < 2; ++db)
#pragma unroll
                for (int s2 = 0; s2 < 2; ++s2) {
                    const s16x4 lo = tr_read(vad[0][db] + kt * 4096 + s2 * 2048), hh = tr_read(vad[1][db] + kt * 4096 + s2 * 2048);
                    const bf16x8v vf = (bf16x8v){lo[0], lo[1], lo[2], lo[3], hh[0], hh[1], hh[2], hh[3]};
                    o[db] = __builtin_amdgcn_mfma_f32_32x32x16_bf16(vf, pb[kt][s2], o[db], 0, 0, 0);
                }
        const float inv = 1.0f / lrow;
        unsigned char* op = (unsigned char*)F.X1B + qrow * 768 + a.g * 256 + 64 * a.j + 16 * hi;
#pragma unroll
        for (int db = 0; db < 2; ++db) { unsigned px[2], py[2];
#pragma unroll
            for (int rp = 0; rp < 2; ++rp) { int ta = 0, tb = 0;
                ta = __builtin_amdgcn_cvt_pk_fp8_f32(o[db][8 * rp] * inv, o[db][8 * rp + 1] * inv, ta, false); ta = __builtin_amdgcn_cvt_pk_fp8_f32(o[db][8 * rp + 2] * inv, o[db][8 * rp + 3] * inv, ta, true);
                tb = __builtin_amdgcn_cvt_pk_fp8_f32(o[db][8 * rp + 4] * inv, o[db][8 * rp + 5] * inv, tb, false); tb = __builtin_amdgcn_cvt_pk_fp8_f32(o[db][8 * rp + 6] * inv, o[db][8 * rp + 7] * inv, tb, true);
                const auto rx = __builtin_amdgcn_permlane32_swap((unsigned)ta, (unsigned)tb, false, false);
                px[rp] = rx[0]; py[rp] = rx[1]; }
            const auto sx_ = __builtin_amdgcn_permlane32_swap(px[0], px[1], false, false), sy_ = __builtin_amdgcn_permlane32_swap(py[0], py[1], false, false);
            *(GAS v4u*)(op + 32 * db) = (v4u){sx_[0], sy_[0], sx_[1], sy_[1]}; }
        if (hi == 0) lse[qrow * 12 + a.g * 4 + a.j] = mrow + log2f(lrow);
        asm volatile("s_waitcnt lgkmcnt(0)" ::: "memory");
        __builtin_amdgcn_s_barrier(); asm volatile("" ::: "memory");
    }
#undef ATTN_LOAD_Q
#undef ATTN_CVT_Q
    asm volatile("s_waitcnt vmcnt(0)" ::: "memory");
    __syncthreads();
}
__device__ __forceinline__ void p2_attn_mfma(Frame& F) {
    LAS unsigned char* vl = F.lds + F.wave * 4096;
    float* lse = (float*)F.list;
    const int gw = F.vcu * NWAVES + F.wave, NGW = F.G * NWAVES;
    for (int rep_ = 0; rep_ < 1 + ((REPEAT_MASK >> 2) & 1); ++rep_)
    for (int u = gw; u < 3 * 4096; u += NGW) attn_unit(F, u, vl, lse);
}
__device__ __forceinline__ void p3_merge(Frame& F) {
    const float* lse = (const float*)F.list;
    const int gw = F.vcu * NWAVES + F.wave, NGW = F.G * NWAVES;
    const int j = F.lane >> 4;
    constexpr int NT = 8;
    for (int t4 = gw * NT; t4 < T; t4 += NGW * NT) {
        float l[NT][3]; unsigned p[NT][3]; float o4[NT][4], mo[NT];
#pragma unroll
        for (int q = 0; q < NT; ++q) { const float* lp = lse + (size_t)(t4 + q) * 12 + j; const unsigned char* pp = (const unsigned char*)F.X1B + (size_t)(t4 + q) * 768 + 4 * F.lane;
#pragma unroll
            for (int g = 0; g < 3; ++g) { l[q][g] = lp[4 * g]; p[q][g] = *(const GAS unsigned*)(pp + 256 * g); } }
#pragma unroll
        for (int q = 0; q < NT; ++q) {
            const float mx = fmaxf(l[q][0], fmaxf(l[q][1], l[q][2]));
            const float e0 = fast_exp2(l[q][0] - mx), e1 = fast_exp2(l[q][1] - mx), e2 = fast_exp2(l[q][2] - mx);
            const float inv = 1.0f / (e0 + e1 + e2);
            const float w0 = e0 * inv, w1 = e1 * inv, w2 = e2 * inv;
            const pg8::f32x2_t a01 = __builtin_amdgcn_cvt_pk_f32_fp8((int)p[q][0], false), a23 = __builtin_amdgcn_cvt_pk_f32_fp8((int)p[q][0], true), b01 = __builtin_amdgcn_cvt_pk_f32_fp8((int)p[q][1], false), b23 = __builtin_amdgcn_cvt_pk_f32_fp8((int)p[q][1], true),
                                 c01 = __builtin_amdgcn_cvt_pk_f32_fp8((int)p[q][2], false), c23 = __builtin_amdgcn_cvt_pk_f32_fp8((int)p[q][2], true);
            o4[q][0] = w0 * a01[0] + w1 * b01[0] + w2 * c01[0]; o4[q][1] = w0 * a01[1] + w1 * b01[1] + w2 * c01[1];
            o4[q][2] = w0 * a23[0] + w1 * b23[0] + w2 * c23[0]; o4[q][3] = w0 * a23[1] + w1 * b23[1] + w2 * c23[1];
            mo[q] = fmaxf(fmaxf(fabsf(o4[q][0]), fabsf(o4[q][1])), fmaxf(fabsf(o4[q][2]), fabsf(o4[q][3])));
        }
#pragma unroll
        for (int o = 1; o < 64; o <<= 1) {
#pragma unroll
            for (int q = 0; q < NT; ++q) mo[q] = fmaxf(mo[q], __shfl_xor(mo[q], o)); }
#pragma unroll
        for (int q = 0; q < NT; ++q) { const float amax = fmaxf(mo[q], 1e-20f), qs = 127.0f / amax;
            if (F.lane == 0) F.sO[t4 + q] = amax * (1.0f / 127.0f);
            *((GAS unsigned*)((unsigned char*)(F.PROJ + (size_t)(t4 + q) * PROJ_LD) + 256) + F.lane) = pack4_i8(o4[q][0] * qs, o4[q][1] * qs, o4[q][2] * qs, o4[q][3] * qs); }
    }
}

__device__ __forceinline__ void w13_slot(Frame& F, int slot) {
    LAS float* scr = (LAS float*)(F.lds + F.wave * 16384);
    const int par = F.vcu & 1, rank = F.vcu >> 1, nr = (F.G + 1 - par) >> 1;
    constexpr int PER_E = 256 * 2, PER_SLOT = NEXP * PER_E / 4;
    const int lane = F.lane, kr = lane >> 3, nc = 4 * (lane & 7), step = nr * NWAVES, end = (slot + 1) * PER_SLOT;
#define W13_DECODE(it_) const int e_ = (it_) / PER_E; int r_ = (it_) % PER_E; const int which_ = r_ >> 8; r_ &= 255; const int nb_ = r_ & 15, kb_ = r_ >> 4, n0_ = 32 * nb_; \
        const float* W_ = (which_ ? F.w3 : F.w1) + (size_t)e_ * D * FF
#define W13_LOAD(it_, v_) do { W13_DECODE(it_); _Pragma("unroll") for (int i = 0; i < 8; ++i) v_[i] = __builtin_nontemporal_load((const GAS f32x4*)(W_ + (size_t)(64 * kb_ + 8 * i + kr) * FF + n0_ + nc)); } while (0)
    f32x4 va[8], vb[8];
    int it = slot * PER_SLOT + rank * NWAVES + F.wave;
    if (it < end) W13_LOAD(it, va);
    for (; it < end; it += step) {
        if (it + step < end) W13_LOAD(it + step, vb);
        W13_DECODE(it);
        (void)W_;
        float sc[8];
#pragma unroll
        for (int i = 0; i < 8; ++i) sc[i] = F.g_ffn[64 * kb_ + 8 * i + kr] * W13_SCALE;
#pragma unroll
        for (int i = 0; i < 8; ++i) { LAS float* d = scr + (8 * i + kr) * 33 + nc; const f32x4 t = va[i] * sc[i]; d[0] = t.x; d[1] = t.y; d[2] = t.z; d[3] = t.w; }
        LDS_WAIT(); asm volatile("" ::: "memory");
        const int c = lane & 7; const int drow0 = e_ * 1024 + 256 * (n0_ >> 7) + (n0_ & 127) + 128 * which_;
        pg8::u32x2 pc[4];
#pragma unroll
        for (int j = 0; j < 4; ++j) { const int n = (lane >> 3) + 8 * j; const LAS float* sp = scr + (8 * c) * 33 + n;
            const f32x4 a = {sp[0 * 33], sp[1 * 33], sp[2 * 33], sp[3 * 33]}, b = {sp[4 * 33], sp[5 * 33], sp[6 * 33], sp[7 * 33]};
            pc[j] = pg8::pack8_fp8(a, b); }
#pragma unroll
        for (int j = 0; j < 4; j += 2) { unsigned char* pa = F.W13Q + (size_t)(drow0 + (lane >> 3) + 8 * j) * D + 64 * kb_ + 8 * c;
            store2x8_x1(pa, pa + (size_t)8 * D, pc[j], pc[j + 1], lane); }
        LDS_WAIT(); asm volatile("" ::: "memory");
#pragma unroll
        for (int i = 0; i < 8; ++i) va[i] = vb[i];
    }
#undef W13_LOAD
#undef W13_DECODE
    __syncthreads();
}
__device__ __forceinline__ void p5_stage_router(Frame& F) {
    constexpr int WROW = 2064;
    LAS unsigned char* wimg = F.lds;
    for (int q = F.wave; q < 96; q += NWAVES)
        __builtin_amdgcn_global_load_lds((const unsigned*)((const char*)F.WrT + (size_t)(q >> 1) * 2048 + (q & 1) * 1024 + F.lane * 16), (LAS unsigned*)(wimg + (q >> 1) * WROW + (q & 1) * 1024), 16, 0, 0);
}
__device__ __forceinline__ void p5_route(Frame& F, const bool prestaged) {
    const int gw = F.vcu * NWAVES + F.wave, NGW = F.G * NWAVES;
    LAS unsigned* hist = (LAS unsigned*)(F.lds + L_HIST);
    LAS unsigned* lbase = (LAS unsigned*)(F.lds + L_LBASE);
    LAS unsigned* rec = (LAS unsigned*)(F.lds + L_REC);
    if (F.tid < 128) rec[F.tid * 8 + 7] = 0xffffffffu;
    __syncthreads();
    {
        constexpr int WROW = 2064, WIMG = 48 * WROW;
        LAS unsigned char* wimg = F.lds;
        if (!prestaged) p5_stage_router(F);
        VM_WAIT(); __syncthreads();
        LAS float* lg = (LAS float*)(F.lds + ((WIMG + 255) & ~255) + F.wave * 3328);
        const int row = F.lane & 15, kq = F.lane >> 4;
        for (int tile = gw; tile < T / 16; tile += NGW) {
            const int t0 = tile * 16;
            const bf16* xp = F.X1B + (size_t)(t0 + row) * D + 8 * kq;
            const LAS unsigned char* wp = wimg + row * WROW + 16 * kq;
            pg8::f32x4 a0 = {0.f, 0.f, 0.f, 0.f}, a1 = a0, a2 = a0; float ss = 0.f;
            for (int rep_ = 0; rep_ < 1 + ((REPEAT_MASK >> 11) & 1); ++rep_) {
            asm volatile("" :: "v"(a0), "v"(a1), "v"(a2), "v"(ss));
            a0 = (pg8::f32x4){0.f, 0.f, 0.f, 0.f}; a1 = a0; a2 = a0; ss = 0.f;
#pragma unroll 8
            for (int c = 0; c < 32; ++c) {
                const v4u xr_ = *(const GAS v4u*)(xp + 32 * c);
                const pg8::bf16x8 xa = __builtin_bit_cast(pg8::bf16x8, xr_);
                const pg8::bf16x8 w0 = *(const LAS pg8::bf16x8*)(wp + 64 * c), w1 = *(const LAS pg8::bf16x8*)(wp + 16 * WROW + 64 * c), w2 = *(const LAS pg8::bf16x8*)(wp + 32 * WROW + 64 * c);
#pragma unroll
                for (int z = 0; z < 4; ++z) { const float lo = bflo(xr_[z]), hi_ = bfhi(xr_[z]); ss += lo * lo + hi_ * hi_; }
                a0 = __builtin_amdgcn_mfma_f32_16x16x32_bf16(xa, w0, a0, 0, 0, 0); a1 = __builtin_amdgcn_mfma_f32_16x16x32_bf16(xa, w1, a1, 0, 0, 0); a2 = __builtin_amdgcn_mfma_f32_16x16x32_bf16(xa, w2, a2, 0, 0, 0);
            }
            }
            ss += __shfl_xor(ss, 16); ss += __shfl_xor(ss, 32);
            const float rstd = 1.0f / sqrtf(ss * (1.f / D) + RMS_EPS);
#pragma unroll
            for (int q = 0; q < 4; ++q) { const int tok = 4 * kq + q; lg[tok * 49 + row] = a0[q]; lg[tok * 49 + 16 + row] = a1[q]; lg[tok * 49 + 32 + row] = a2[q]; }
            if (kq == 0) lg[16 * 49 + row] = rstd;
            LDS_WAIT(); asm volatile("" ::: "memory");
            if (F.lane < 16) {
                const int t = t0 + F.lane; const LAS float* lr = lg + F.lane * 49; const float rs = lg[16 * 49 + F.lane];
                float c[4];
#pragma unroll
                for (int q = 0; q < 4; ++q) c[q] = lr[q] * rs + F.b_rg[q];
                int gi = 0; float cm = c[0];
#pragma unroll
                for (int q = 1; q < 4; ++q) if (c[q] > cm) { cm = c[q]; gi = q; }
                float den = 0.f;
#pragma unroll
                for (int q = 0; q < 4; ++q) den += expf(c[q] - cm);
                const float pg = 1.0f / den;
                float f[8];
#pragma unroll
                for (int q = 0; q < 8; ++q) f[q] = lr[4 + 8 * gi + q] * rs + F.b_re[8 * gi + q];
                int i0 = 0; float f0 = f[0];
#pragma unroll
                for (int q = 1; q < 8; ++q) if (f[q] > f0) { f0 = f[q]; i0 = q; }
                int i1 = -1; float f1 = -3.0e38f;
#pragma unroll
                for (int q = 0; q < 8; ++q) if (q != i0 && f[q] > f1) { f1 = f[q]; i1 = q; }
                const float dd = expf(f1 - f0);
                const float w0 = pg / (1.0f + dd), w1 = pg * dd / (1.0f + dd);
                const int e0 = 8 * gi + i0, e1 = 8 * gi + i1;
                const unsigned r0 = __hip_atomic_fetch_add(hist + e0, 1u, __ATOMIC_RELAXED, __HIP_MEMORY_SCOPE_WORKGROUP);
                const unsigned r1 = __hip_atomic_fetch_add(hist + e1, 1u, __ATOMIC_RELAXED, __HIP_MEMORY_SCOPE_WORKGROUP);
                LAS unsigned* rc = rec + (F.wave * 16 + F.lane) * 8;
                rc[0] = (unsigned)e0; rc[1] = r0; rc[2] = __builtin_bit_cast(unsigned, w0); rc[3] = (unsigned)e1; rc[4] = r1; rc[5] = __builtin_bit_cast(unsigned, w1); rc[6] = __builtin_bit_cast(unsigned, rs); rc[7] = (unsigned)t;
            }
            LDS_WAIT(); asm volatile("" ::: "memory");
        }
    }
    __syncthreads();
    if (F.tid < NEXP) { const unsigned hh = hist[F.tid]; lbase[F.tid] = hh ? __hip_atomic_fetch_add((unsigned*)(F.ctl + CW_CNT + 64 * F.tid), hh, RLX_AGENT) : 0u; }
    __syncthreads();
    if (F.tid < 128) {
        const LAS unsigned* rc = rec + F.tid * 8;
        const unsigned t = rc[7];
        if (t != 0xffffffffu) {
            const int e0 = (int)rc[0], e1 = (int)rc[3];
            const int p0 = (int)(lbase[e0] + rc[1]), p1 = (int)(lbase[e1] + rc[4]);
            const float rstd = __builtin_bit_cast(float, rc[6]);
            F.list[(size_t)e0 * CAP + p0] = (int)t; F.wl[(size_t)e0 * CAP + p0] = __builtin_bit_cast(float, rc[2]); F.rsl[(size_t)e0 * CAP + p0] = rstd;
            F.list[(size_t)e1 * CAP + p1] = (int)t; F.wl[(size_t)e1 * CAP + p1] = __builtin_bit_cast(float, rc[5]); F.rsl[(size_t)e1 * CAP + p1] = rstd;
            *((GAS v4i*)F.tokinfo + t) = (v4i){e0, p0, e1, p1};
        }
    }
}

__device__ __forceinline__ void moe_prefix(Frame& F, int& cnt_e, int& excl, int& incl) {
    int c = 0; if (F.lane < NEXP) { c = (int)__hip_atomic_load((unsigned*)(F.ctl + CW_CNT + 64 * F.lane), RLX_AGENT); if (c > CAP) c = CAP; }
    int v = (c + 255) >> 8;
#pragma unroll
    for (int o = 1; o < 32; o <<= 1) { const int t = __shfl_up(v, o); if ((F.lane & 31) >= o) v += t; }
    cnt_e = c; incl = v; excl = v - ((c + 255) >> 8);
}
__device__ __forceinline__ int moe_tables(Frame& F, bool want_gather) {
    LAS int* cntl = (LAS int*)(F.lds + L_CNT);
    LAS int* tpre = (LAS int*)(F.lds + L_TPRE);
    LAS int* nu = (LAS int*)(F.lds + L_NU);
    LAS int* utab = (LAS int*)(F.lds + L_UTAB);
    LAS int* gtab = (LAS int*)(F.lds + L_GTAB);
    if (F.wave == 0) {
        int c, excl, incl;
        if (want_gather) { moe_prefix(F, c, excl, incl); if (F.lane < NEXP) { cntl[F.lane] = c; tpre[F.lane] = excl; } }
        else { c = F.lane < NEXP ? cntl[F.lane] : 0; excl = F.lane < NEXP ? tpre[F.lane] : 0; incl = excl + ((c + 255) >> 8); }
        const int total = __shfl(incl, NEXP - 1);
        if (F.lane == 0) tpre[NEXP] = total;
        const int nunits = total * 4; int n = 0;
        for (int i = 0; i < MAXU; ++i) { const int L = i * F.G + F.vcu; if (L >= nunits) break;
            const int rt = L >> 2, pnl = L & 3;
            const unsigned long long hit = __ballot(F.lane < NEXP && excl <= rt && rt < incl);
            const int e = __builtin_ctzll(hit);
            const int ex = __shfl(excl, e), ce = __shfl(c, e);
            const int pos0 = (rt - ex) * 256; int rows = ce - pos0; if (rows > 256) rows = 256;
            if (F.lane == 0) { utab[i * 8 + 0] = rt; utab[i * 8 + 1] = e * 4 + pnl; utab[i * 8 + 2] = e; utab[i * 8 + 3] = pos0; utab[i * 8 + 4] = rows; }
            n = i + 1; }
        if (F.lane == 0) nu[0] = n;
    }
    __syncthreads();
    const int n = nu[0];
    if (want_gather) {
        for (int idx = F.tid; idx < n * 256; idx += NWAVES * 64) { const int i = idx >> 8, r = idx & 255; const int e = utab[i * 8 + 2], pos0 = utab[i * 8 + 3], rows = utab[i * 8 + 4];
            gtab[idx] = r < rows ? F.list[(size_t)e * CAP + pos0 + r] : 0; }
        __syncthreads();
    }
    return __builtin_amdgcn_readfirstlane(n);
}

__device__ __forceinline__ void p7_w2_copy(Frame& F, int n_mine) {
    const LAS int* tpre = (const LAS int*)(F.lds + L_TPRE);
    const int nunits = tpre[NEXP] * 4, full = nunits / F.G, rem = nunits - full * F.G;
    int nidle = F.G - rem, rank = F.vcu - rem;
    if (rem == 0 || nidle < 64) { nidle = F.G; rank = F.vcu; }
    if (rank < 0) return;
    (void)n_mine;
    LAS float* scr = (LAS float*)(F.lds + F.wave * 16384);
    for (int it = rank * NWAVES + F.wave; it < NEXP * 256; it += nidle * NWAVES) {
        const int e = it >> 8, r = it & 255; const int nb = r & 31, kb = r >> 5;
        tr_item_q(F.w2 + (size_t)e * FF * D, D, 64 * kb, 32 * nb, F.W2Q, FF, e * 1024 + 32 * nb, 64 * kb, nullptr, W2_SCALE, scr, F.lane);
    }
}
struct FinalPre { v4i ti[4]; v2u xb[4][4]; };
__device__ __forceinline__ void p8_prefetch(Frame& F, FinalPre& P) {
    const int t0 = (F.vcu * NWAVES + F.wave) * 4;
    if (t0 < T) {
#pragma unroll
        for (int q = 0; q < 4; ++q) { P.ti[q] = *((const GAS v4i*)F.tokinfo + t0 + q); const GAS v2u* xr = (const GAS v2u*)(F.X1B + (size_t)(t0 + q) * D) + F.lane;
#pragma unroll
            for (int j = 0; j < 4; ++j) P.xb[q][j] = xr[64 * j]; } }
}
__device__ __forceinline__ void p8_final(Frame& F, FinalPre& P, const bool pre) {
    LAS int* tpre = (LAS int*)(F.lds + L_TPRE);
    const int gw = F.vcu * NWAVES + F.wave, NGW = F.G * NWAVES;
    f32x4 gf[4];
#pragma unroll
    for (int j = 0; j < 4; ++j) gf[j] = *((const GAS f32x4*)F.g_fin + F.lane + 64 * j);
    if (!pre) p8_prefetch(F, P);
    v4i ti[4];
#pragma unroll
    for (int q = 0; q < 4; ++q) ti[q] = P.ti[q];
    for (int t4 = gw * 4; t4 < T; t4 += NGW * 4) {
        v2u xb[4][4]; unsigned ya[4][4], yb[4][4];
        if (t4 == gw * 4) {
#pragma unroll
            for (int q = 0; q < 4; ++q)
#pragma unroll
                for (int j = 0; j < 4; ++j) xb[q][j] = P.xb[q][j];
        } else {
#pragma unroll
        for (int q = 0; q < 4; ++q) { const GAS v2u* xr = (const GAS v2u*)(F.X1B + (size_t)(t4 + q) * D) + F.lane;
#pragma unroll
            for (int j = 0; j < 4; ++j) xb[q][j] = xr[64 * j]; }
        }
#pragma unroll
        for (int q = 0; q < 4; ++q) {
            const size_t s0 = (size_t)tpre[ti[q].x] * 256 + ti[q].y, s1 = (size_t)tpre[ti[q].z] * 256 + ti[q].w;
            const GAS unsigned* y0 = (const GAS unsigned*)(F.Y + s0 * D) + F.lane; const GAS unsigned* y1 = (const GAS unsigned*)(F.Y + s1 * D) + F.lane;
#pragma unroll
            for (int j = 0; j < 4; ++j) { ya[q][j] = y0[64 * j]; yb[q][j] = y1[64 * j]; }
        }
        { const int tn = t4 + NGW * 4; if (tn < T) {
#pragma unroll
            for (int q = 0; q < 4; ++q) ti[q] = *((const GAS v4i*)F.tokinfo + tn + q); } }
        f32x4 z[4][4]; float sq[4];
#pragma unroll
        for (int q = 0; q < 4; ++q) {
#pragma unroll
            for (int j = 0; j < 4; ++j) { const v2u xb_ = xb[q][j]; const f32x4 xv = {bflo(xb_.x), bfhi(xb_.x), bflo(xb_.y), bfhi(xb_.y)}; const unsigned a = ya[q][j], b = yb[q][j];
                const pg8::f32x2_t a01 = __builtin_amdgcn_cvt_pk_f32_fp8((int)a, false), a23 = __builtin_amdgcn_cvt_pk_f32_fp8((int)a, true), b01 = __builtin_amdgcn_cvt_pk_f32_fp8((int)b, false), b23 = __builtin_amdgcn_cvt_pk_f32_fp8((int)b, true);
                z[q][j].x = xv.x + (a01[0] + b01[0]) * (1.0f / Y_SCALE); z[q][j].y = xv.y + (a01[1] + b01[1]) * (1.0f / Y_SCALE); z[q][j].z = xv.z + (a23[0] + b23[0]) * (1.0f / Y_SCALE); z[q][j].w = xv.w + (a23[1] + b23[1]) * (1.0f / Y_SCALE); }
        }
#pragma unroll
        for (int q = 0; q < 4; ++q) { float ss = 0.f;
#pragma unroll
            for (int j = 0; j < 4; ++j) ss += (z[q][j].x * z[q][j].x + z[q][j].y * z[q][j].y) + (z[q][j].z * z[q][j].z + z[q][j].w * z[q][j].w);
            sq[q] = ss; }
#pragma unroll
        for (int o = 1; o < 64; o <<= 1) {
#pragma unroll
            for (int q = 0; q < 4; ++q) sq[q] += __shfl_xor(sq[q], o); }
#pragma unroll
        for (int q = 0; q < 4; ++q) { const float rstd = 1.0f / sqrtf(sq[q] * (1.f / D) + RMS_EPS);
            GAS f32x4* xr = (GAS f32x4*)(F.out + (size_t)(t4 + q) * D) + F.lane;
#pragma unroll
            for (int j = 0; j < 4; ++j) __builtin_nontemporal_store(z[q][j] * rstd * gf[j], xr + 64 * j); }
    }
}

constexpr int N_PHASES = 10;
struct Args { const float* in[17]; float* out; unsigned char* ws; int ph_lo, ph_hi, li, pad; };
__global__ void __launch_bounds__(NWAVES * 64, 2) fwd_kernel(Args args) {
    extern __shared__ __attribute__((aligned(16))) unsigned char lds[];
    Frame F;
    F.lds = (LAS unsigned char*)lds;
    F.tid = threadIdx.x; F.lane = F.tid & 63; F.wave = __builtin_amdgcn_readfirstlane(F.tid >> 6);
    F.G = gridDim.x; { const int bx = blockIdx.x; F.vcu = (F.G % 8 == 0) ? (bx % 8) * (F.G / 8) + bx / 8 : bx; }
    unsigned char* ws = args.ws;
    F.ctl = (gu32*)(ws + WS_CTL);
    F.x = args.in[0]; F.g_mix = args.in[1]; F.w_in = args.in[2]; F.b_gate = args.in[3]; F.conv_w = args.in[4]; F.w_ao = args.in[5]; F.w_co = args.in[6]; F.w_out = args.in[7];
    F.g_ffn = args.in[8]; F.w_rg = args.in[9]; F.b_rg = args.in[10]; F.w_re = args.in[11]; F.b_re = args.in[12]; F.w1 = args.in[13]; F.w3 = args.in[14]; F.w2 = args.in[15]; F.g_fin = args.in[16];
    F.out = args.out;
    F.WinT = (bf16*)(ws + WS_WIN); F.WacT = (bf16*)(ws + WS_WAC); F.WoT = (bf16*)(ws + WS_WO); F.W13Q = (unsigned char*)args.out;     F.W2Q = ws + WS_W2; F.X1Q = ws + WS_X1Q; F.HIDQ = ws + WS_HID; F.XNQ = (unsigned char*)args.out + 64 * MiB; F.WinQ = ws + WS_WINQ;
    F.PROJ = (bf16*)(ws + WS_PROJ); F.XN = (bf16*)args.out; F.X1B = (bf16*)(ws + WS_X1B); F.Y = ws + WS_Y; F.irs1 = (float*)(ws + WS_IRS1);
    F.list = (int*)(ws + WS_LIST); F.wl = (float*)(ws + WS_WL); F.rsl = (float*)(ws + WS_RSL); F.tokinfo = (int*)(ws + WS_TOKINFO); F.WrT = (float*)(ws + WS_WRT); F.sO = (float*)(ws + 26 * MiB); F.sC = (float*)(ws + 26 * MiB + 512 * 1024);
    {
        constexpr int CODE_WARM_BYTES = 136 * 1024;
        const GAS unsigned char* pc = (const GAS unsigned char*)(__builtin_amdgcn_s_getpc() & ~(unsigned long long)255);
        const int off = (F.vcu & 31) * 8192 + F.tid * 16;
        if (off < CODE_WARM_BYTES) { const v4u w = *(const GAS v4u*)(pc + off); asm volatile("" :: "v"(w)); }
    }
    for (int u = F.tid; u < (LDS_ZERO_END - L_MISC) / 4; u += NWAVES * 64) ((LAS unsigned*)(F.lds + L_MISC))[u] = 0u;
    __syncthreads();
    volatile LAS unsigned* MISC = (volatile LAS unsigned*)(F.lds + L_MISC);
    XcdBarrier bar; bar.bar = (unsigned*)(F.ctl + CW_BAR); bar.x = 0; bar.st = nullptr;
    if (MK_N_LAUNCHES == 1) bar = xcd_barrier_post((unsigned*)(F.ctl + CW_BAR), MISC + 8);
#define GRID_BAR() do { if (MK_N_LAUNCHES == 1) xcd_barrier(bar); } while (0)
    const int lo = args.ph_lo, hi = args.ph_hi;
#ifndef PHASE_MASK
#define PHASE_MASK 0x3ff
#endif
#define IN(k) (((PHASE_MASK >> (k)) & 1) && lo <= (k) && (k) < hi)
#define BOTH(k) (IN(k) && IN((k) + 1))

    FinalPre fpre;
    if (IN(0)) { TWICE(0, p0_prologue(F);); if (BOTH(0)) GRID_BAR(); }
    if (IN(1)) {
        TWICE(1,
        {
            pg8::Gemm g{(const bf16*)F.XNQ, (const bf16*)F.WinT, D / 2, D / 2, D / 2}; pg8::StaticOrder S; S.init(T, NPROJ, F.G, (int)blockIdx.x);
            pg8::EpiProjI8 E{F.PROJ, F.b_gate, F.irs1};
            pg8::gemm_phase<pg8::EpiProjI8, pg8::StaticOrder, true, false, 2>(F.lds, g, S, E);
        }
        );
        if (BOTH(1)) GRID_BAR();
    }
    if (IN(2)) {
#if defined(ATTN_NAIVE)
        p2_conv(F); p2_attn_naive(F);
#else
        p2_conv(F);
#if defined(ATTN_V1)
        p2_attn_mfma(F);
#else
        p2_attn_v2(F);
#endif
#endif
        if (BOTH(2)) GRID_BAR(); }
    if (IN(3)) {
#if !defined(ATTN_NAIVE)
        TWICE(3, p3_merge(F););
#endif
        if (BOTH(3) && MK_N_LAUNCHES == 1 && (F.vcu & 1)) { xcd_barrier_arrive(bar); w13_slot(F, 0); xcd_barrier_wait(bar); }
        else if (BOTH(3)) GRID_BAR(); }
    if (IN(4)) {
        if ((F.vcu & 1) && !(BOTH(3) && MK_N_LAUNCHES == 1)) w13_slot(F, 0);
        TWICE(4,
        pg8::Gemm g{(const bf16*)((const unsigned char*)F.PROJ + 256), F.WacT, D / 2, PROJ_LD, WAC_LDB / 2}; pg8::StaticOrder S; S.init(T, D, F.G, (int)blockIdx.x);
        pg8::EpiMerged E{F.PROJ, F.irs1, F.sO, F.sC};
        pg8::gemm_phase<pg8::EpiMerged, pg8::StaticOrder, true, false, 2>(F.lds, g, S, E);
        );
        if (!(F.vcu & 1)) { if (BOTH(4) && MK_N_LAUNCHES == 1) xcd_barrier_arrive(bar); w13_slot(F, 1); if (BOTH(4) && MK_N_LAUNCHES == 1) xcd_barrier_wait(bar); }
        else if (BOTH(4)) GRID_BAR();
    }
    if (IN(5)) {
        if (F.vcu & 1) w13_slot(F, 2);
        TWICE(5,
        pg8::Gemm g{(const bf16*)((const unsigned char*)F.PROJ + 2048), F.WoT, D / 2, PROJ_LD, D / 2}; pg8::StaticOrder S; S.init(T, D, F.G, (int)blockIdx.x);
        pg8::EpiOut E{F.x, F.X1B, F.X1Q, F.irs1};
        pg8::gemm_phase<pg8::EpiOut, pg8::StaticOrder, EPI_ALIGN_OUT, false, 2>(F.lds, g, S, E);
        );
        if (!(F.vcu & 1)) { if (BOTH(5) && MK_N_LAUNCHES == 1) xcd_barrier_arrive(bar); w13_slot(F, 3); if (BOTH(5)) { p5_stage_router(F); if (MK_N_LAUNCHES == 1) xcd_barrier_wait(bar); } }
        else if (BOTH(5)) {
            if (MK_N_LAUNCHES == 1) { xcd_barrier_arrive(bar); p5_stage_router(F); xcd_barrier_wait(bar); } else { __syncthreads(); p5_stage_router(F); } }
    }
    if (IN(6)) { p5_route(F, IN(5)); if (BOTH(6)) GRID_BAR(); }
    if (IN(7)) {
        TWICE(7,
        const int n = moe_tables(F, true);
        pg8::Gemm g{(const bf16*)F.X1Q, (const bf16*)F.W13Q, D / 2, D / 2, D / 2}; pg8::MoeOrder S{(const LAS int*)(F.lds + L_UTAB), (const LAS int*)(F.lds + L_GTAB), n};
        pg8::EpiHid E{F.HIDQ, F.rsl};
        pg8::gemm_phase<pg8::EpiHid, pg8::MoeOrder, true, true, true>(F.lds, g, S, E);
        );
        p7_w2_copy(F, 0);
        if (BOTH(7)) GRID_BAR();
    }
    if (IN(8)) {
        TWICE(8,
        const int n = moe_tables(F, false);
        pg8::Gemm g{(const bf16*)F.HIDQ, (const bf16*)F.W2Q, FF / 2, FF / 2, FF / 2}; pg8::MoeOrder S{(const LAS int*)(F.lds + L_UTAB), (const LAS int*)(F.lds + L_GTAB), n};
        pg8::EpiY E{F.Y, F.wl};
        pg8::gemm_phase<pg8::EpiY, pg8::MoeOrder, true, false, true>(F.lds, g, S, E);
        );
        if (BOTH(8)) { if (MK_N_LAUNCHES == 1) { xcd_barrier_arrive(bar); p8_prefetch(F, fpre); xcd_barrier_wait(bar); } else p8_prefetch(F, fpre); }
    }
    if (IN(9)) { p8_final(F, fpre, IN(8)); }
#undef IN
#undef BOTH
#undef GRID_BAR
}

extern "C" void kernel_launch(void* const* d_in, const int* in_sizes, int n_in, void* d_out, int out_size, void* d_ws, size_t ws_size, hipStream_t stream) {
    static int grid = 0;
    if (grid == 0) {
        if (n_in != 17 || in_sizes[0] != T * D || out_size != T * D || ws_size < WS_END) { fprintf(stderr, "kernel_launch: unexpected shapes (n_in %d, in0 %d, out %d, ws %zu)\n", n_in, n_in > 0 ? in_sizes[0] : -1, out_size, ws_size); grid = -1; return; }
        int dev = 0, cus = 0, per_cu = 0;
        if (hipGetDevice(&dev) != hipSuccess || hipDeviceGetAttribute(&cus, hipDeviceAttributeMultiprocessorCount, dev) != hipSuccess) { grid = -1; return; }
        if (hipFuncSetAttribute((const void*)fwd_kernel, hipFuncAttributeMaxDynamicSharedMemorySize, LDS_BYTES) != hipSuccess) { fprintf(stderr, "kernel_launch: hipFuncSetAttribute failed\n"); grid = -1; return; }
        if (hipOccupancyMaxActiveBlocksPerMultiprocessor(&per_cu, (const void*)fwd_kernel, NWAVES * 64, LDS_BYTES) != hipSuccess || per_cu < 1)
            fprintf(stderr, "kernel_launch: note: occupancy query reports %d workgroups per CU\n", per_cu);
        (void)hipGetLastError();
        grid = cus;
        if (grid != 256) fprintf(stderr, "kernel_launch: warning: %d CUs (built for 256)\n", grid);
    }
    if (grid < 0) return;
    (void)hipMemsetAsync((char*)d_ws + WS_CTL, 0, CTL_ZERO_BYTES, stream);
    Args a{};
    for (int i = 0; i < 17; ++i) a.in[i] = (const float*)d_in[i];
    a.out = (float*)d_out; a.ws = (unsigned char*)d_ws;
    if (MK_N_LAUNCHES == 1) {
#if defined(PROBE_PREFIX)
        a.ph_lo = 0; a.ph_hi = PROBE_PREFIX; a.li = 0;
        hipLaunchKernelGGL(fwd_kernel, dim3(grid), dim3(NWAVES * 64), LDS_BYTES, stream, a);
        (void)hipMemsetAsync((char*)d_ws + WS_CTL, 0, CTL_ZERO_BYTES, stream);
#endif
        a.ph_lo = 0; a.ph_hi = N_PHASES; a.li = 0;
        hipLaunchKernelGGL(fwd_kernel, dim3(grid), dim3(NWAVES * 64), LDS_BYTES, stream, a);
    } else {
        for (int p = 0; p < N_PHASES; ++p) { a.ph_lo = p; a.ph_hi = p + 1; a.li = p; hipLaunchKernelGGL(fwd_kernel, dim3(grid), dim3(NWAVES * 64), LDS_BYTES, stream, a); }
    }
}
```
